# Optimizing an MI355X kernel written in HIP

```python
import jax, jax.numpy as jnp
from jax import lax
import numpy as np

D_MODEL = 1024
BATCH = 8
SEQ = 4096
DEPTH = 1
DEC_BATCH = 128
DEC_SEQ = 8
PAST_LEN = 16384
PAGE_SIZE = 128

SW_HEADS = 8
SW_KV_HEADS = 2
SW_GROUP = SW_HEADS // SW_KV_HEADS
SW_HEAD_DIM = 64
WINDOW = 128
SW_BLOCK = 128
HG_HEADS = 4
HG_KEY_DIM = 128
HG_VAL_DIM = 128
HG_CHUNK = 64
MEM_LEN = 256
MX_HEADS = 4
MX_HEAD_DIM = 128

SW_Q = SW_HEADS * SW_HEAD_DIM
SW_KV = SW_KV_HEADS * SW_HEAD_DIM
HG_K = HG_HEADS * HG_KEY_DIM
HG_V = HG_HEADS * HG_VAL_DIM
MX_W = MX_HEADS * MX_HEAD_DIM
N_BRANCH = 3
IN_SIZES = (SW_Q, SW_KV, SW_KV, HG_K, HG_K, HG_V, HG_V, MX_W, N_BRANCH * D_MODEL)
IN_WIDTH = sum(IN_SIZES)
IN_OFFSETS = tuple(int(o) for o in np.cumsum(IN_SIZES)[:-1])
D_FF = ((8 * D_MODEL + 3 * 256 - 1) // (3 * 256)) * 256
ALPHA = (2.0 * DEPTH) ** 0.25
BETA = (8.0 * DEPTH) ** -0.25
LN_EPS = 1e-5
RMS_EPS = 1e-6

kernel_name = 'hybrid_swa_sink_hgrn2_memory_decode_step'


def layer_norm(x, w, b):
    xf = x.astype(jnp.float32)
    mu = jnp.mean(xf, axis=-1, keepdims=True)
    var = jnp.mean(jnp.square(xf - mu), axis=-1, keepdims=True)
    return ((xf - mu) * lax.rsqrt(var + LN_EPS) * w.astype(jnp.float32) + b.astype(jnp.float32)).astype(x.dtype)


def alibi_slopes(n):
    return 2.0 ** (-8.0 * jnp.arange(1, n + 1, dtype=jnp.float32) / n)


def sink_attention(q, k, v, dist, valid, sinks):
    s = jnp.einsum('bnqkgd,bnskd->bnkgqs', q, k, preferred_element_type=jnp.float32) * (SW_HEAD_DIM ** -0.5)
    slopes = alibi_slopes(SW_HEADS).reshape(SW_KV_HEADS, SW_GROUP)[:, :, None, None]
    s = s - slopes * dist[:, None, None].astype(jnp.float32)
    s = jnp.where(valid[:, None, None], s, -jnp.inf)
    sink = sinks.astype(jnp.float32).reshape(SW_KV_HEADS, SW_GROUP)[:, :, None, None]
    m = jnp.maximum(jnp.max(s, axis=-1, keepdims=True), sink)
    p = jnp.exp(s - m)
    denom = jnp.sum(p, axis=-1, keepdims=True) + jnp.exp(sink - m)
    return jnp.einsum('bnkgqs,bnskd->bnqkgd', (p / denom).astype(v.dtype), v)


def window_attention_prompt(q, k, v, sinks):
    B, T = q.shape[:2]
    nb = T // SW_BLOCK
    qb = q.reshape(B, nb, SW_BLOCK, SW_KV_HEADS, SW_GROUP, SW_HEAD_DIM)

    def with_prev(a):
        a = a.reshape(B, nb, SW_BLOCK, SW_KV_HEADS, SW_HEAD_DIM)
        prev = jnp.concatenate([jnp.zeros_like(a[:, :1]), a[:, :-1]], axis=1)
        return jnp.concatenate([prev, a], axis=2)

    kk, vv = with_prev(k), with_prev(v)
    blk = jnp.arange(nb)[:, None] * SW_BLOCK
    qpos = blk + jnp.arange(SW_BLOCK)[None]
    kpos = blk - SW_BLOCK + jnp.arange(2 * SW_BLOCK)[None]
    dist = qpos[:, :, None] - kpos[:, None, :]
    valid = (dist >= 0) & (dist < WINDOW) & (kpos[:, None, :] >= 0)
    o = sink_attention(qb, kk, vv, dist, valid, sinks)
    return o.reshape(B, T, SW_Q)


def window_attention_sample(q, k, v, k_buf, v_buf, sinks):
    B, T = q.shape[:2]
    W = k_buf.shape[1]
    kk = jnp.concatenate([k_buf, k], axis=1)
    vv = jnp.concatenate([v_buf, v], axis=1)
    qpos = PAST_LEN + jnp.arange(T)
    kpos = jnp.concatenate([PAST_LEN - W + jnp.arange(W), PAST_LEN + jnp.arange(T)])
    dist = (qpos[:, None] - kpos[None, :])[None]
    valid = (dist >= 0) & (dist < WINDOW)
    o = sink_attention(q.reshape(B, 1, T, SW_KV_HEADS, SW_GROUP, SW_HEAD_DIM),
                       kk[:, None], vv[:, None], dist, valid, sinks)
    return o.reshape(B, T, SW_Q), kk[:, -W:], vv[:, -W:]


def hgrn2_chunkwise(q, k, v, logf, s0):
    B, T = q.shape[:2]
    C = min(HG_CHUNK, T)
    nc = -(-T // C)
    pad = nc * C - T

    def blocks(a):
        a = jnp.pad(a, ((0, 0), (0, pad), (0, 0), (0, 0)))
        return a.reshape(B, nc, C, a.shape[2], a.shape[3]).transpose(1, 0, 3, 2, 4)

    causal = jnp.tril(jnp.ones((C, C), dtype=bool))[:, :, None]

    def step(S, inp):
        qc, kc, vc, gc = inp
        b = jnp.cumsum(gc, axis=2)
        o_inter = jnp.einsum('bhtd,bhde->bhte', qc * jnp.exp(b), S)
        diff = b[:, :, :, None, :] - b[:, :, None, :, :]
        decay = jnp.exp(jnp.where(causal, diff, -jnp.inf))
        A = jnp.einsum('bhtd,bhsd,bhtsd->bhts', qc, kc, decay)
        o = o_inter + jnp.einsum('bhts,bhse->bhte', A, vc)
        b_last = b[:, :, -1:, :]
        S_new = jnp.exp(b_last[:, :, 0, :])[..., None] * S + jnp.einsum('bhsd,bhse->bhde', kc * jnp.exp(b_last - b), vc)
        return S_new, o

    S_fin, o = lax.scan(step, s0, (blocks(q), blocks(k), blocks(v), blocks(logf)))
    o = o.transpose(1, 0, 3, 2, 4).reshape(B, nc * C, q.shape[2], v.shape[3])[:, :T]
    return o, S_fin


def memory_attention(q, mem_k, mem_v):
    B, T = q.shape[:2]
    s = jnp.einsum('bthd,bshd->bhts', q, mem_k, preferred_element_type=jnp.float32) * (MX_HEAD_DIM ** -0.5)
    p = jax.nn.softmax(s, axis=-1)
    return jnp.einsum('bhts,bshd->bthd', p.astype(mem_v.dtype), mem_v).reshape(B, T, MX_W)


def decoder_layer(x, k_buf, v_buf, hg_s0, mem_k, mem_v, lw):
    B, T, _ = x.shape
    f32 = jnp.float32
    proj = x @ lw['w_in']
    sq, sk, sv, hq, hf, hi, hg, mq, gl = jnp.split(proj, IN_OFFSETS, axis=-1)
    sq = sq.reshape(B, T, SW_HEADS, SW_HEAD_DIM)
    sk = sk.reshape(B, T, SW_KV_HEADS, SW_HEAD_DIM)
    sv = sv.reshape(B, T, SW_KV_HEADS, SW_HEAD_DIM)
    if k_buf is None:
        o_sw = window_attention_prompt(sq, sk, sv, lw['sinks'])
        new_k, new_v = sk[:, T - WINDOW:], sv[:, T - WINDOW:]
    else:
        o_sw, new_k, new_v = window_attention_sample(sq, sk, sv, k_buf, v_buf, lw['sinks'])
    lb = lw['hg_lb']
    f = lb + (1.0 - lb) * jax.nn.sigmoid(hf.astype(f32))
    hshape = (B, T, HG_HEADS, HG_KEY_DIM)
    q_h = jax.nn.silu(hq.astype(f32)).reshape(hshape)
    k_h = (1.0 - f).reshape(hshape)
    logf = jnp.log(f).reshape(hshape)
    v_h = hi.astype(f32).reshape(B, T, HG_HEADS, HG_VAL_DIM)
    s0 = jnp.zeros((B, HG_HEADS, HG_KEY_DIM, HG_VAL_DIM), f32) if hg_s0 is None else hg_s0.astype(f32)
    o_h, s_fin = hgrn2_chunkwise(q_h, k_h, v_h, logf, s0)
    o_h = o_h * lax.rsqrt(jnp.mean(jnp.square(o_h), axis=-1, keepdims=True) + RMS_EPS) * lw['hg_norm_w'].astype(f32)
    o_h = (o_h.reshape(B, T, HG_V) * jax.nn.silu(hg.astype(f32))).astype(x.dtype)
    o_m = memory_attention(mq.reshape(B, T, MX_HEADS, MX_HEAD_DIM), mem_k, mem_v)
    g = jax.nn.sigmoid(gl.astype(f32)).reshape(B, T, N_BRANCH, D_MODEL).astype(x.dtype)
    mix = (g[:, :, 0] * (o_sw @ lw['w_up_sw'])
           + g[:, :, 1] * (o_h @ lw['w_up_hg'])
           + g[:, :, 2] * (o_m @ lw['w_up_mx']))
    h = layer_norm(ALPHA * x + mix @ lw['w_o'], lw['ln1_w'], lw['ln1_b'])
    ff_gate, ff_up = jnp.split(h @ lw['w_ffn_in'], 2, axis=-1)
    y = layer_norm(ALPHA * h + (jax.nn.silu(ff_gate) * ff_up) @ lw['w_ffn_out'], lw['ln2_w'], lw['ln2_b'])
    return y, new_k, new_v, s_fin


def setup_inputs(seed: int = 0) -> dict:
    key = jax.random.key(seed)
    ks = jax.random.split(key, 26)

    def nrm(k, shape, scale=1.0):
        return jax.random.normal(k, shape, jnp.float32) * scale

    win_buf = min(WINDOW, PAST_LEN)
    return {
        'x_prompt': nrm(ks[0], (BATCH, SEQ, D_MODEL)),
        'x_sample': nrm(ks[1], (DEC_BATCH, DEC_SEQ, D_MODEL)),
        'cache_k_win': nrm(ks[2], (DEPTH, DEC_BATCH, win_buf, SW_KV_HEADS, SW_HEAD_DIM)),
        'cache_v_win': nrm(ks[3], (DEPTH, DEC_BATCH, win_buf, SW_KV_HEADS, SW_HEAD_DIM)),
        'state_hgrn': nrm(ks[4], (DEPTH, DEC_BATCH, HG_HEADS, HG_KEY_DIM, HG_VAL_DIM), 0.5),
        'cache_mem_k': nrm(ks[5], (DEPTH, DEC_BATCH, MEM_LEN, MX_HEADS, MX_HEAD_DIM)),
        'cache_mem_v': nrm(ks[6], (DEPTH, DEC_BATCH, MEM_LEN, MX_HEADS, MX_HEAD_DIM)),
        'mem_prompt': nrm(ks[7], (BATCH, MEM_LEN, D_MODEL)),
        'ln0_w': 1.0 + nrm(ks[8], (D_MODEL,), 0.02),
        'ln0_b': nrm(ks[9], (D_MODEL,), 0.02),
        'w_in': nrm(ks[10], (DEPTH, D_MODEL, IN_WIDTH), D_MODEL ** -0.5),
        'w_up_sw': nrm(ks[11], (DEPTH, SW_Q, D_MODEL), SW_Q ** -0.5),
        'w_up_hg': nrm(ks[12], (DEPTH, HG_V, D_MODEL), HG_V ** -0.5),
        'w_up_mx': nrm(ks[13], (DEPTH, MX_W, D_MODEL), MX_W ** -0.5),
        'sw_sinks': nrm(ks[14], (DEPTH, SW_HEADS), 0.5),
        'hg_lower_bound': nrm(ks[15], (DEPTH + 1, HG_K), 0.1),
        'hg_norm_w': 1.0 + nrm(ks[16], (DEPTH, HG_VAL_DIM), 0.02),
        'w_mem_kv': nrm(ks[17], (DEPTH, D_MODEL, 2 * MX_W), D_MODEL ** -0.5),
        'w_o': nrm(ks[18], (DEPTH, D_MODEL, D_MODEL), BETA * D_MODEL ** -0.5),
        'ln1_w': 1.0 + nrm(ks[19], (DEPTH, D_MODEL), 0.02),
        'ln1_b': nrm(ks[20], (DEPTH, D_MODEL), 0.02),
        'w_ffn_in': nrm(ks[21], (DEPTH, D_MODEL, 2 * D_FF), D_MODEL ** -0.5),
        'w_ffn_out': nrm(ks[22], (DEPTH, D_FF, D_MODEL), BETA * D_FF ** -0.5),
        'ln2_w': 1.0 + nrm(ks[23], (DEPTH, D_MODEL), 0.02),
        'ln2_b': nrm(ks[24], (DEPTH, D_MODEL), 0.02),
    }


def reference(x_prompt, x_sample, cache_k_win, cache_v_win, state_hgrn, cache_mem_k, cache_mem_v, mem_prompt,
              ln0_w, ln0_b, w_in, w_up_sw, w_up_hg, w_up_mx, sw_sinks, hg_lower_bound, hg_norm_w, w_mem_kv,
              w_o, ln1_w, ln1_b, w_ffn_in, w_ffn_out, ln2_w, ln2_b):
    lower = jnp.cumsum(jax.nn.softmax(hg_lower_bound.astype(jnp.float32), axis=0), axis=0)
    xp = layer_norm(x_prompt, ln0_w, ln0_b)
    xs = layer_norm(x_sample, ln0_w, ln0_b)
    bp = mem_prompt.shape[0]
    kp_l, vp_l, sp_l, mkp_l, mvp_l, ks_l, vs_l, ss_l = [], [], [], [], [], [], [], []
    for l in range(DEPTH):
        lw = {'w_in': w_in[l], 'w_up_sw': w_up_sw[l], 'w_up_hg': w_up_hg[l], 'w_up_mx': w_up_mx[l],
              'sinks': sw_sinks[l], 'hg_lb': lower[l], 'hg_norm_w': hg_norm_w[l], 'w_o': w_o[l],
              'ln1_w': ln1_w[l], 'ln1_b': ln1_b[l], 'w_ffn_in': w_ffn_in[l], 'w_ffn_out': w_ffn_out[l],
              'ln2_w': ln2_w[l], 'ln2_b': ln2_b[l]}
        mkv = (mem_prompt @ w_mem_kv[l]).reshape(bp, MEM_LEN, 2, MX_HEADS, MX_HEAD_DIM)
        mk, mv = mkv[:, :, 0], mkv[:, :, 1]
        xp, kp, vp, sp = decoder_layer(xp, None, None, None, mk, mv, lw)
        xs, ks_, vs_, ss = decoder_layer(xs, cache_k_win[l], cache_v_win[l], state_hgrn[l],
                                         cache_mem_k[l], cache_mem_v[l], lw)
        kp_l.append(kp); vp_l.append(vp); sp_l.append(sp); mkp_l.append(mk); mvp_l.append(mv)
        ks_l.append(ks_); vs_l.append(vs_); ss_l.append(ss)
    return (xp, xs,
            jnp.stack(kp_l), jnp.stack(vp_l), jnp.stack(sp_l), jnp.stack(mkp_l), jnp.stack(mvp_l),
            jnp.stack(ks_l), jnp.stack(vs_l), jnp.stack(ss_l))
```

```cpp
#include <hip/hip_runtime.h>
#include <hip/hip_cooperative_groups.h>
#include <cstdio>
#include <cstdint>
namespace cg = cooperative_groups;

#define LAS __attribute__((address_space(3)))
typedef unsigned short bf16_t;
typedef short bf16x8 __attribute__((ext_vector_type(8)));
typedef short s16x4 __attribute__((ext_vector_type(4)));
typedef float f32x4 __attribute__((ext_vector_type(4)));
typedef float f32x2 __attribute__((ext_vector_type(2)));
typedef float f32x16 __attribute__((ext_vector_type(16)));
typedef unsigned u32x4 __attribute__((ext_vector_type(4)));
typedef unsigned u32x2 __attribute__((ext_vector_type(2)));
typedef __bf16 bfv2 __attribute__((ext_vector_type(2)));
#define DI __device__ __forceinline__

constexpr int DM = 1024, BATCH = 8, SEQ = 4096, DECB = 128, DECS = 8;
constexpr int MP = BATCH * SEQ, MS = DECB * DECS, MT = MP + MS;
constexpr int NPJ = 6400;
constexpr int C_SQ = 0, C_SK = 512, C_HQ = 768, C_HF = 1280, C_HI = 1792, C_HG = 2304, C_MQ = 2816, C_GL = 3328;
constexpr int C_MIX = 3328, C_Z = 0, C_H = 1024, C_ACT = 2048;
constexpr int DFF = 2816;
constexpr float ALPHA = 1.189207115f;
constexpr float LOG2E = 1.4426950408889634f;
constexpr size_t O_YP = 0, O_YS = 33554432, O_KWP = 34603008, O_VWP = 34734080, O_SP = 34865152, O_MKP = 35389440, O_MVP = 36438016,
                 O_KWS = 37486592, O_VWS = 39583744, O_SS = 41680896;
constexpr size_t S_WTIN = 0, S_WTMKV = 13107200, S_WTUP = 15204352, S_WTO = 18350080, S_WTF1 = 20447232, S_WTF2 = 31981568,
                 S_XN = 37748736, S_MKB = 111149056, S_MVT = 113246208, S_VTSW = 115343360, S_LB = 123731968, S_KSW = 123736064;
constexpr size_t W_PROJ = 0, W_HST = 432537600, W_HD = 466092032, W_BAR = 466354176, W_ZP = 466370560, W_END = 466370560 + 8388608;

DI unsigned pk2(float lo, float hi) { f32x2 v = {lo, hi}; bfv2 b = __builtin_convertvector(v, bfv2); return __builtin_bit_cast(unsigned, b); }
DI bf16_t f2bf(float x) { return (bf16_t)(pk2(x, 0.f) & 0xffffu); }
DI float bf2f(bf16_t b) { return __uint_as_float(((unsigned)b) << 16); }
DI float bflo(unsigned w) { return __uint_as_float(w << 16); }
DI float bfhi(unsigned w) { return __uint_as_float(w & 0xffff0000u); }
DI float fexp2(float x) { return __builtin_amdgcn_exp2f(x); }
DI float fexp(float x) { return __builtin_amdgcn_exp2f(x * LOG2E); }
DI float frcp(float x) { return __builtin_amdgcn_rcpf(x); }
DI float fsigmoid(float x) { return frcp(1.0f + fexp(-x)); }
DI float fsilu(float x) { return x * fsigmoid(x); }
DI float flog(float x) { return __builtin_amdgcn_logf(x) * 0.6931471805599453f; }
DI u32x4 pack8(f32x4 a, f32x4 b) { u32x4 w; w.x = pk2(a[0], a[1]); w.y = pk2(a[2], a[3]); w.z = pk2(b[0], b[1]); w.w = pk2(b[2], b[3]); return w; }
DI bf16x8 ld8f_bf(const float* p) { const f32x4 a = __builtin_nontemporal_load((const f32x4*)p), b = __builtin_nontemporal_load((const f32x4*)(p + 4));     return __builtin_bit_cast(bf16x8, pack8(a, b)); }

namespace pg8 {
constexpr int BM = 256, BK = 64, HALF = 128, HTB = HALF * BK * 2, STAGE_BYTES = 8 * HTB, NXCD = 8, WGM = 8;
__host__ __device__ __forceinline__ int lds_byte(int r, int c) { const int st = (r >> 4) * 2 + (c >> 5), rr = r & 15, cc = c & 31, ob = rr * 64 + cc * 2; return st * 1024 + (ob ^ (((ob >> 9) & 1) << 5)); }
__host__ __device__ __forceinline__ void stage_rc(int b, int& R, int& C) { const int st = b / 1024, sb = b % 1024, swz = sb ^ (((sb >> 9) & 1) << 5); R = (st >> 1) * 16 + swz / 64; C = (st & 1) * 32 + (swz % 64) / 2; }
__host__ __device__ __forceinline__ int perm32(int rho) { const int n = rho >> 4, i = rho & 15; return 8 * (i >> 2) + 4 * n + (i & 3); }
struct Unit { int pm, pn, k; };
DI void swz_tile(int L, int nM, int nN, int& pm, int& pn) {
    const int nwg = nM * nN; int wgid = L; { const int q = nwg / NXCD, r = nwg % NXCD, xcd = wgid % NXCD, off = wgid / NXCD; wgid = (xcd < r ? xcd * (q + 1) : r * (q + 1) + (xcd - r) * q) + off; }
    const int nig = WGM * nN, gid = wgid / nig, fm = gid * WGM, gsz = (nM - fm) < WGM ? (nM - fm) : WGM;
    pm = fm + ((wgid % nig) % gsz); pn = (wgid % nig) / gsz;
}
template <class Epi, class Sched>
DI void gemm_phase(LAS unsigned char* lds, const Sched& S, const Epi& E) {
    const int tid = threadIdx.x, wid = __builtin_amdgcn_readfirstlane(tid >> 6), lane = tid & 63, wr = wid >> 2, wc = wid & 3, fr = lane & 15, fq = lane >> 4;
    const int K = S.K, lda = S.lda, ldb = S.ldb(), nt = K / BK;
    unsigned voffA[2], voffB[2];
#pragma unroll
    for (int i = 0; i < 2; ++i) { int R, C; stage_rc(tid * 16 + i * 8192, R, C); const int Rb = (R & ~31) + perm32(R & 31);
        voffA[i] = (unsigned)(R * lda + C) * 2u; voffB[i] = (unsigned)(Rb * ldb + C) * 2u; }
    const size_t kstep = (size_t)(BK * 2);
    const size_t hstepA = (size_t)HALF * lda * 2, hstepB = (size_t)HALF * ldb * 2;
    const unsigned ldsw = (unsigned)wid * 1024u;
    const int aoff = lds_byte(wr * 64 + fr, fq * 8), boff = lds_byte(wc * 32 + fr, fq * 8);
#define PG8_SA(b, h) (((b) * 2 + (h)) * HTB)
#define PG8_SB(b, h) ((4 + (b) * 2 + (h)) * HTB)
#define PG8_STAGE(bufoff, gbase, voff) do { _Pragma("unroll") for (int _i = 0; _i < 2; ++_i) \
        __builtin_amdgcn_global_load_lds((const unsigned*)((const char*)(gbase) + (voff)[_i]), (LAS unsigned*)(lds + (bufoff) + ldsw + _i * 8192), 16, 0, 0); } while (0)
#define PG8_LDA(dst, b, h) do { _Pragma("unroll") for (int m = 0; m < 4; ++m) _Pragma("unroll") for (int k = 0; k < 2; ++k) dst[m][k] = *(const LAS bf16x8*)(lds + PG8_SA(b, h) + aoff + m * 2048 + k * 1024); } while (0)
#define PG8_LDB(dst, b, h) do { _Pragma("unroll") for (int n = 0; n < 2; ++n) _Pragma("unroll") for (int k = 0; k < 2; ++k) dst[n][k] = *(const LAS bf16x8*)(lds + PG8_SB(b, h) + boff + n * 2048 + k * 1024); } while (0)
#define PG8_MMA(ai, bj, At, Bt) do { __builtin_amdgcn_s_setprio(1); _Pragma("unroll") for (int m = 0; m < 4; ++m) _Pragma("unroll") for (int n = 0; n < 2; ++n) _Pragma("unroll") for (int k = 0; k < 2; ++k) \
        acc[ai][bj][m][n] = __builtin_amdgcn_mfma_f32_16x16x32_bf16(Bt[n][k], At[m][k], acc[ai][bj][m][n], 0, 0, 0); __builtin_amdgcn_s_setprio(0); } while (0)
#define PG8_WAIT_V(n) asm volatile("s_waitcnt vmcnt(" #n ")" ::: "memory")
#define PG8_WAIT_L(n) asm volatile("s_waitcnt lgkmcnt(" #n ")" ::: "memory")
#define PG8_BAR __builtin_amdgcn_s_barrier()
#define PG8_SCHED __builtin_amdgcn_sched_barrier(0)
    Unit cur, nxt; int ui = 0;
    if (!S.next(0, cur)) return;
    f32x4 acc[2][2][4][2];
#pragma unroll
    for (int a = 0; a < 2; ++a)
#pragma unroll
        for (int b = 0; b < 2; ++b)
#pragma unroll
            for (int m = 0; m < 4; ++m)
#pragma unroll
                for (int n = 0; n < 2; ++n) acc[a][b][m][n] = (f32x4){0.f, 0.f, 0.f, 0.f};
    bf16x8 At[4][2], B0[2][2], B1[2][2];
    const char* cA = S.pa(cur); const char* cB = S.pb(cur);
    PG8_STAGE(PG8_SB(0, 0), cB, voffB); PG8_STAGE(PG8_SB(0, 1), cB + hstepB, voffB); PG8_STAGE(PG8_SA(0, 0), cA, voffA); PG8_STAGE(PG8_SA(0, 1), cA + hstepA, voffA);
    if (wr == 1) PG8_BAR;
    PG8_WAIT_V(2); PG8_BAR;
    PG8_STAGE(PG8_SB(1, 0), cB + kstep, voffB); PG8_STAGE(PG8_SA(1, 0), cA + kstep, voffA); PG8_STAGE(PG8_SB(1, 1), cB + hstepB + kstep, voffB);
    PG8_WAIT_V(6); PG8_BAR;
    for (;;) {
        const bool has_next = S.next(ui + 1, nxt);
        const char* nA = has_next ? S.pa(nxt) : cA; const char* nB = has_next ? S.pb(nxt) : cB;
        for (int t = 0; t < nt; t += 2) {
            const bool last = (t == nt - 2);
            const char* a1 = cA + (size_t)(t + 1) * kstep;
            const char* a2 = last ? nA : cA + (size_t)(t + 2) * kstep; const char* b2 = last ? nB : cB + (size_t)(t + 2) * kstep;
            const char* a3 = a2 + kstep; const char* b3 = b2 + kstep;
            PG8_LDB(B0, 0, 0); PG8_LDB(B1, 0, 1); PG8_SCHED; PG8_LDA(At, 0, 0); PG8_STAGE(PG8_SA(1, 1), a1 + hstepA, voffA);
            PG8_WAIT_V(8); PG8_WAIT_L(0); PG8_BAR; PG8_MMA(0, 0, At, B0); PG8_MMA(0, 1, At, B1); PG8_BAR; PG8_SCHED;
            PG8_LDA(At, 0, 1); PG8_STAGE(PG8_SB(0, 0), b2, voffB); PG8_STAGE(PG8_SB(0, 1), b2 + hstepB, voffB); PG8_STAGE(PG8_SA(0, 0), a2, voffA);
            PG8_WAIT_V(8); PG8_WAIT_L(0); PG8_BAR; PG8_MMA(1, 0, At, B0); PG8_MMA(1, 1, At, B1); PG8_BAR; PG8_SCHED;
            PG8_LDB(B0, 1, 0); PG8_LDB(B1, 1, 1); PG8_SCHED; PG8_LDA(At, 1, 0); PG8_STAGE(PG8_SA(0, 1), a2 + hstepA, voffA);
            PG8_WAIT_V(8); PG8_WAIT_L(0); PG8_BAR; PG8_MMA(0, 0, At, B0); PG8_MMA(0, 1, At, B1); PG8_BAR; PG8_SCHED;
            PG8_LDA(At, 1, 1); PG8_STAGE(PG8_SB(1, 0), b3, voffB); PG8_STAGE(PG8_SB(1, 1), b3 + hstepB, voffB); PG8_STAGE(PG8_SA(1, 0), a3, voffA);
            PG8_WAIT_V(8); PG8_WAIT_L(0); PG8_BAR; PG8_MMA(1, 0, At, B0); PG8_MMA(1, 1, At, B1); PG8_BAR; PG8_SCHED;
        }
        if (wr == 0) PG8_BAR;
        E(acc, cur, wr, wc, fr, fq);
        if (!has_next) break;
#pragma unroll
        for (int a = 0; a < 2; ++a)
#pragma unroll
            for (int b = 0; b < 2; ++b)
#pragma unroll
                for (int m = 0; m < 4; ++m)
#pragma unroll
                    for (int n = 0; n < 2; ++n) acc[a][b][m][n] = (f32x4){0.f, 0.f, 0.f, 0.f};
        cur = nxt; cA = nA; cB = nB; ++ui;
        if (wr == 1) PG8_BAR;
    }
    PG8_WAIT_V(0);
    PG8_BAR;
#undef PG8_SA
#undef PG8_SB
#undef PG8_STAGE
#undef PG8_LDA
#undef PG8_LDB
#undef PG8_MMA
#undef PG8_WAIT_V
#undef PG8_WAIT_L
#undef PG8_BAR
#undef PG8_SCHED
}
}
using pg8::Unit;

struct Params {
    const float* in[25];
    float* out;
    unsigned char* ws;
    int ph_lo, ph_hi;
};
enum { I_XP = 0, I_XS, I_CK, I_CV, I_ST, I_CMK, I_CMV, I_MEM, I_LN0W, I_LN0B, I_WIN, I_WSW, I_WHG, I_WMX, I_SINK, I_LBND, I_HNW, I_WMKV, I_WO, I_LN1W, I_LN1B,
       I_WF1, I_WF2, I_LN2W, I_LN2B };

struct SchedIn {
    int K, lda, G, c; const char* A; const char* B;
    DI int ldb() const { return K; }
    DI bool next(int i, Unit& u) const { const int L = i * G + c; if (L >= 3332) return false;
        if (L < 3300) pg8::swz_tile(L, 132, 25, u.pm, u.pn); else { const int l = L - 3300; u.pm = 132 + (l >> 2); u.pn = 25 + (l & 3); } u.k = 0; return true; }
    DI const char* pa(const Unit& u) const { return A + (size_t)u.pm * (256 * 1024 * 2); }
    DI const char* pb(const Unit& u) const { return B + (size_t)u.pn * (256 * 1024 * 2); }
};
struct SchedUp {
    int K, lda, G, c; const char* A; const char* B;
    DI int ldb() const { return K; }
    DI bool next(int i, Unit& u) const { const int L = (i / 3) * G + c; if (L >= 512) return false; pg8::swz_tile(L, 128, 4, u.pm, u.pn); u.k = i % 3; return true; }
    DI const char* pa(const Unit& u) const { const int co = u.k == 0 ? C_SQ : (u.k == 1 ? C_HQ : C_MQ); return A + (size_t)u.pm * (256 * (size_t)NPJ * 2) + co * 2; }
    DI const char* pb(const Unit& u) const { return B + (size_t)(u.k * 1024 + u.pn * 256) * (512 * 2); }
};
struct SchedUpS {
    int K, lda, pm, pn; const char* A; const char* B;
    DI int ldb() const { return K; }
    DI bool next(int i, Unit& u) const { if (i >= 3) return false; u.pm = pm; u.pn = pn; u.k = i; return true; }
    DI const char* pa(const Unit& u) const { const int co = u.k == 0 ? C_SQ : (u.k == 1 ? C_HQ : C_MQ); return A + (size_t)u.pm * (256 * (size_t)NPJ * 2) + co * 2; }
    DI const char* pb(const Unit& u) const { return B + (size_t)(u.k * 1024 + u.pn * 256) * (512 * 2); }
};
struct SchedOne {
    int K, lda, pm, pn; const char* A; const char* B;
    DI int ldb() const { return K; }
    DI bool next(int i, Unit& u) const { if (i >= 1) return false; u.pm = pm; u.pn = pn; u.k = 0; return true; }
    DI const char* pa(const Unit& u) const { return A + (size_t)u.pm * (256 * (size_t)lda * 2); }
    DI const char* pb(const Unit& u) const { return B + (size_t)u.pn * (256 * (size_t)K * 2); }
};
struct SchedHalfK {
    int K, lda, pm, pn, half; const char* A; const char* B;
    DI int ldb() const { return DFF; }
    DI bool next(int i, Unit& u) const { if (i >= 1) return false; u.pm = pm; u.pn = pn; u.k = half; return true; }
    DI const char* pa(const Unit& u) const { return A + (size_t)u.pm * (256 * (size_t)lda * 2) + (size_t)half * (1408 * 2); }
    DI const char* pb(const Unit& u) const { return B + (size_t)u.pn * (256 * (size_t)DFF * 2) + (size_t)half * (1408 * 2); }
};
struct SchedPlain {
    int K, lda, G, c; const char* A; const char* B; int nM, nN;
    DI int ldb() const { return K; }
    DI bool next(int i, Unit& u) const { const int L = i * G + c; if (L >= nM * nN) return false; pg8::swz_tile(L, nM, nN, u.pm, u.pn); u.k = 0; return true; }
    DI const char* pa(const Unit& u) const { return A + (size_t)u.pm * (256 * (size_t)lda * 2); }
    DI const char* pb(const Unit& u) const { return B + (size_t)u.pn * (256 * (size_t)K * 2); }
};

typedef f32x4 Acc[2][2][4][2];
struct EpiIn {
    bf16_t* proj; float* out; const float* lb; bf16_t* mkb; bf16_t* mvt; bf16_t* vtsw; bf16_t* ksw; int mode;
    DI void operator()(Acc& acc, const Unit& u, int wr, int wc, int fr, int fq) const {
        asm volatile("" : "+v"(fr), "+v"(fq));
        const int pn = u.pn;
        f32x4 lbv[2][2];
        if (u.pm < 132 && (pn == 5 || pn == 6)) {
#pragma unroll
            for (int bj = 0; bj < 2; ++bj) { const int c = (pn - 5) * 256 + bj * 128 + wc * 32 + fq * 8; lbv[bj][0] = *(const f32x4*)(lb + c); lbv[bj][1] = *(const f32x4*)(lb + c + 4); }
        }
        if (u.pm >= 132) {
            const int b = u.pm - 132, kv = (pn - 25) >> 1;
#pragma unroll
            for (int ai = 0; ai < 2; ++ai)
#pragma unroll
                for (int m = 0; m < 4; ++m) { const int s = ai * 128 + wr * 64 + m * 16 + fr;
#pragma unroll
                    for (int bj = 0; bj < 2; ++bj) { const int h = 2 * ((pn - 25) & 1) + bj, d = wc * 32 + fq * 8;
                        const f32x4 v0 = acc[ai][bj][m][0], v1 = acc[ai][bj][m][1];
                        float* o = out + (kv ? O_MVP : O_MKP) + ((size_t)(b * 256 + s) * 4 + h) * 128 + d;
                        *(f32x4*)o = v0; *(f32x4*)(o + 4) = v1;
                        if (kv == 0) *(u32x4*)(mkb + ((((((size_t)(b * 4 + h) * 8 + (s >> 5)) * 8 + (d >> 4)) * 2 + ((d >> 3) & 1)) * 32 + (s & 31)) * 8)) = pack8(v0, v1);
                        else { const int w16 = s & 15; bf16_t* t = mvt + (((((size_t)(b * 4 + h) * 16 + (s >> 4)) * 2 + ((w16 >> 2) & 1)) * 128 + d) * 8) + (w16 & 3) + 4 * (w16 >> 3);
#pragma unroll
                            for (int j = 0; j < 4; ++j) { t[j * 8] = f2bf(v0[j]); t[(4 + j) * 8] = f2bf(v1[j]); } } } }
            return;
        }
#pragma unroll
        for (int ai = 0; ai < 2; ++ai)
#pragma unroll
            for (int m = 0; m < 4; ++m) { const int row = u.pm * 256 + ai * 128 + wr * 64 + m * 16 + fr;
                bf16_t* prow = proj + (size_t)row * NPJ + pn * 256 + wc * 32 + fq * 8;
#pragma unroll
                for (int bj = 0; bj < 2; ++bj) { f32x4 v0 = acc[ai][bj][m][0], v1 = acc[ai][bj][m][1];
                    if (pn == 2) {
                        const int kvh = wc >> 1, d = (wc & 1) * 32 + fq * 8;
                        float* o = nullptr;
                        if (row >= MP) { const int bs = (row - MP) >> 3, t = (row - MP) & 7; o = out + (bj ? O_VWS : O_KWS) + ((size_t)(bs * 128 + 120 + t) * 2 + kvh) * 64 + d; }
                        else { const int t = row & 4095; if (t >= 3968) o = out + (bj ? O_VWP : O_KWP) + ((size_t)((row >> 12) * 128 + t - 3968) * 2 + kvh) * 64 + d; }
                        if (o) { *(f32x4*)o = v0; *(f32x4*)(o + 4) = v1; }
                        if (row < MP) { const int tt = row & 4095, bk = ((row >> 12) * 2 + kvh);
                            if (bj == 0) *(u32x4*)(ksw + ((((((size_t)bk * 128 + (tt >> 5)) * 4 + (d >> 4)) * 2 + ((d >> 3) & 1)) * 32 + (tt & 31)) * 8)) = pack8(v0, v1);
                            else { const int w16 = tt & 15; bf16_t* t = vtsw + (((((size_t)bk * 256 + (tt >> 4)) * 2 + ((w16 >> 2) & 1)) * 64 + d) * 8) + (w16 & 3) + 4 * (w16 >> 3);
#pragma unroll
                                for (int j = 0; j < 4; ++j) { t[j * 8] = f2bf(v0[j]); t[(4 + j) * 8] = f2bf(v1[j]); } } }
                        continue;
                    }
                    if (pn < 2) { v0 *= 0.125f * LOG2E; v1 *= 0.125f * LOG2E; }
                    else if (pn < 5 || (pn >= 9 && pn < 11)) {
#pragma unroll
                        for (int j = 0; j < 4; ++j) { v0[j] = fsilu(v0[j]); v1[j] = fsilu(v1[j]); } }
                    else if (pn < 7) { const f32x4 l0 = lbv[bj][0], l1 = lbv[bj][1];
#pragma unroll
                        for (int j = 0; j < 4; ++j) { v0[j] = flog(l0[j] + (1.0f - l0[j]) * fsigmoid(v0[j])); v1[j] = flog(l1[j] + (1.0f - l1[j]) * fsigmoid(v1[j])); } }
                    else if (pn < 9) {}
                    else if (pn < 13) { v0 *= 0.08838834764831845f * LOG2E; v1 *= 0.08838834764831845f * LOG2E; }
                    else {
#pragma unroll
                        for (int j = 0; j < 4; ++j) { v0[j] = fsigmoid(v0[j]); v1[j] = fsigmoid(v1[j]); } }
                    const u32x4 w8 = pack8(v0, v1);
                    if (mode == 0) __builtin_nontemporal_store(w8, (u32x4*)(prow + bj * 128)); else asm volatile("" :: "v"(w8));
                } }
    }
};
struct EpiUp {
    bf16_t* proj; bool dry;
    DI void operator()(Acc& acc, const Unit& u, int wr, int wc, int fr, int fq) const {
        asm volatile("" : "+v"(fr), "+v"(fq));
        bf16_t* base = proj + (size_t)(u.pm * 256 + wr * 64 + fr) * NPJ + C_GL + u.pn * 256 + wc * 32 + fq * 8;
        {
            u32x4 g[2][4][2];
#pragma unroll
            for (int ai = 0; ai < 2; ++ai)
#pragma unroll
                for (int m = 0; m < 4; ++m)
#pragma unroll
                    for (int bj = 0; bj < 2; ++bj) g[ai][m][bj] = *(const u32x4*)(base + (size_t)(ai * 128 + m * 16) * NPJ + u.k * 1024 + bj * 128);
#pragma unroll
            for (int ai = 0; ai < 2; ++ai)
#pragma unroll
                for (int m = 0; m < 4; ++m)
#pragma unroll
                    for (int bj = 0; bj < 2; ++bj) { const u32x4 q = g[ai][m][bj]; f32x4& v0 = acc[ai][bj][m][0]; f32x4& v1 = acc[ai][bj][m][1];
                        v0[0] *= bflo(q.x); v0[1] *= bfhi(q.x); v0[2] *= bflo(q.y); v0[3] *= bfhi(q.y); v1[0] *= bflo(q.z); v1[1] *= bfhi(q.z); v1[2] *= bflo(q.w); v1[3] *= bfhi(q.w); }
        }
        if (u.k > 0) {
            u32x4 g[2][4][2];
#pragma unroll
            for (int ai = 0; ai < 2; ++ai)
#pragma unroll
                for (int m = 0; m < 4; ++m)
#pragma unroll
                    for (int bj = 0; bj < 2; ++bj) g[ai][m][bj] = *(const u32x4*)(base + (size_t)(ai * 128 + m * 16) * NPJ + bj * 128);
#pragma unroll
            for (int ai = 0; ai < 2; ++ai)
#pragma unroll
                for (int m = 0; m < 4; ++m)
#pragma unroll
                    for (int bj = 0; bj < 2; ++bj) { const u32x4 q = g[ai][m][bj]; f32x4& v0 = acc[ai][bj][m][0]; f32x4& v1 = acc[ai][bj][m][1];
                        v0[0] += bflo(q.x); v0[1] += bfhi(q.x); v0[2] += bflo(q.y); v0[3] += bfhi(q.y); v1[0] += bflo(q.z); v1[1] += bfhi(q.z); v1[2] += bflo(q.w); v1[3] += bfhi(q.w); }
        }
        if (!dry) {
#pragma unroll
            for (int ai = 0; ai < 2; ++ai)
#pragma unroll
                for (int m = 0; m < 4; ++m)
#pragma unroll
                    for (int bj = 0; bj < 2; ++bj) *(u32x4*)(base + (size_t)(ai * 128 + m * 16) * NPJ + bj * 128) = pack8(acc[ai][bj][m][0], acc[ai][bj][m][1]);
        }
    }
};
struct EpiRes {
    bf16_t* proj; const bf16_t* res; int rp;
    DI void operator()(Acc& acc, const Unit& u, int wr, int wc, int fr, int fq) const {
        asm volatile("" : "+v"(fr), "+v"(fq));
        const int row0 = u.pm * 256 + wr * 64 + fr, col0 = u.pn * 256 + wc * 32 + fq * 8;
        u32x4 g[2][4][2];
#pragma unroll
        for (int ai = 0; ai < 2; ++ai)
#pragma unroll
            for (int m = 0; m < 4; ++m)
#pragma unroll
                for (int bj = 0; bj < 2; ++bj) g[ai][m][bj] = *(const u32x4*)(res + (size_t)(row0 + ai * 128 + m * 16) * rp + col0 + bj * 128);
#pragma unroll
        for (int ai = 0; ai < 2; ++ai)
#pragma unroll
            for (int m = 0; m < 4; ++m)
#pragma unroll
                for (int bj = 0; bj < 2; ++bj) { const u32x4 p = g[ai][m][bj]; f32x4 v0 = acc[ai][bj][m][0], v1 = acc[ai][bj][m][1];
                    v0[0] += ALPHA * bflo(p.x); v0[1] += ALPHA * bfhi(p.x); v0[2] += ALPHA * bflo(p.y); v0[3] += ALPHA * bfhi(p.y);
                    v1[0] += ALPHA * bflo(p.z); v1[1] += ALPHA * bfhi(p.z); v1[2] += ALPHA * bflo(p.w); v1[3] += ALPHA * bfhi(p.w);
                    *(u32x4*)(proj + (size_t)(row0 + ai * 128 + m * 16) * NPJ + C_Z + col0 + bj * 128) = pack8(v0, v1); }
    }
};
struct EpiNull {
    DI void operator()(Acc& acc, const Unit& u, int wr, int wc, int fr, int fq) const {
#pragma unroll
        for (int ai = 0; ai < 2; ++ai)
#pragma unroll
            for (int bj = 0; bj < 2; ++bj)
#pragma unroll
                for (int m = 0; m < 4; ++m)
#pragma unroll
                    for (int n = 0; n < 2; ++n) asm volatile("" :: "v"(acc[ai][bj][m][n]));
    }
};
struct EpiPart {
    float* zp;
    DI void operator()(Acc& acc, const Unit& u, int wr, int wc, int fr, int fq) const {
        asm volatile("" : "+v"(fr), "+v"(fq));
#pragma unroll
        for (int ai = 0; ai < 2; ++ai)
#pragma unroll
            for (int m = 0; m < 4; ++m) { float* p = zp + ((size_t)u.k * 1024 + (size_t)(u.pm - 128) * 256 + ai * 128 + wr * 64 + m * 16 + fr) * 1024 + u.pn * 256 + wc * 32 + fq * 8;
#pragma unroll
                for (int bj = 0; bj < 2; ++bj) { *(f32x4*)(p + bj * 128) = acc[ai][bj][m][0]; *(f32x4*)(p + bj * 128 + 4) = acc[ai][bj][m][1]; } }
    }
};
struct EpiGlu {
    bf16_t* proj; int mode;
    DI void operator()(Acc& acc, const Unit& u, int wr, int wc, int fr, int fq) const {
        asm volatile("" : "+v"(fr), "+v"(fq));
#pragma unroll
        for (int ai = 0; ai < 2; ++ai)
#pragma unroll
            for (int m = 0; m < 4; ++m) { const int row = u.pm * 256 + ai * 128 + wr * 64 + m * 16 + fr;
                f32x4 v0, v1;
#pragma unroll
                for (int j = 0; j < 4; ++j) { v0[j] = fsilu(acc[ai][0][m][0][j]) * acc[ai][1][m][0][j]; v1[j] = fsilu(acc[ai][0][m][1][j]) * acc[ai][1][m][1][j]; }
                const u32x4 w8 = pack8(v0, v1);
                if (mode == 0) *(u32x4*)(proj + (size_t)row * NPJ + C_ACT + u.pn * 128 + wc * 32 + fq * 8) = w8; else asm volatile("" :: "v"(w8)); }
    }
};

DI int crow(int reg, int h) { return (reg & 3) + 8 * (reg >> 2) + 4 * h; }
DI bf16x8 pack_step(const f32x16& x, int s) { u32x4 p; p.x = pk2(x[8 * s], x[8 * s + 1]); p.y = pk2(x[8 * s + 2], x[8 * s + 3]); p.z = pk2(x[8 * s + 4], x[8 * s + 5]); p.w = pk2(x[8 * s + 6], x[8 * s + 7]); return __builtin_bit_cast(bf16x8, p); }
#define MFMA32(a, b, c) __builtin_amdgcn_mfma_f32_32x32x16_bf16((a), (b), (c), 0, 0, 0)
#define MFMA16(a, b, c) __builtin_amdgcn_mfma_f32_16x16x32_bf16((a), (b), (c), 0, 0, 0)

template <class T> DI void attn_item(const T& t) {
    constexpr int D = T::D, NCH = T::NCH;
    const int lane = threadIdx.x & 63, r = lane & 31, h = lane >> 5;
    bf16x8 qf[D / 16], kf[D / 16];
#pragma unroll
    for (int kk = 0; kk < D / 16; ++kk) qf[kk] = t.qfrag(r, 16 * kk + 8 * h);
    const int cbeg = t.cbeg();
    if (!T::VSPLIT) {
#pragma unroll
        for (int kk = 0; kk < D / 16; ++kk) kf[kk] = t.kfrag_t(t.tile(cbeg), kk);
    }
    float m = t.m_init(r), l = t.l_init();
    f32x16 o[D / 32];
#pragma unroll
    for (int dd = 0; dd < D / 32; ++dd)
#pragma unroll
        for (int i = 0; i < 16; ++i) o[dd][i] = 0.f;
    bf16x8 vf[2][D / 32];
#pragma unroll 1
    for (int c = cbeg; c < NCH; ++c) {
        const int tl = t.tile(c);
        if (!T::VSPLIT) {
#pragma unroll
            for (int s2 = 0; s2 < 2; ++s2)
#pragma unroll
                for (int dd = 0; dd < D / 32; ++dd) vf[s2][dd] = t.vfrag_t(tl, s2, dd);
        }
        f32x16 s;
        t.init_s(s, tl);
        if (T::VSPLIT) {
#pragma unroll
            for (int kk = 0; kk < D / 16; ++kk) kf[kk] = t.kfrag_t(tl, kk);
        }
#pragma unroll
        for (int kk = 0; kk < D / 16; ++kk) s = MFMA32(kf[kk], qf[kk], s);
        if (!T::VSPLIT && c + 1 < NCH) {
#pragma unroll
            for (int kk = 0; kk < D / 16; ++kk) kf[kk] = t.kfrag_t(tl + 1, kk); }
        t.post_s(s, tl, r, h);
        float mx = s[0];
#pragma unroll
        for (int i = 1; i < 16; ++i) mx = fmaxf(mx, s[i]);
        mx = fmaxf(mx, __shfl_xor(mx, 32));
        const bool need = mx > m + 8.0f;
        if (__builtin_amdgcn_ballot_w64(need) != 0ull) {
            const float mn = need ? mx : m;
            const float sc = fexp2(m - mn);
            l *= sc; m = mn;
#pragma unroll
            for (int dd = 0; dd < D / 32; ++dd)
#pragma unroll
                for (int i = 0; i < 16; ++i) o[dd][i] *= sc;
        }
        float ps = 0.f;
#pragma unroll
        for (int i = 0; i < 16; ++i) { const float p = fexp2(s[i] - m); s[i] = p; ps += p; }
        ps += __shfl_xor(ps, 32);
        l += ps;
#pragma unroll
        for (int s2 = 0; s2 < 2; ++s2) { const bf16x8 pb = pack_step(s, s2);
            if (T::VSPLIT) {
#pragma unroll
                for (int dd = 0; dd < D / 32; ++dd) vf[s2][dd] = t.vfrag_t(tl, s2, dd);
            }
#pragma unroll
            for (int dd = 0; dd < D / 32; ++dd) o[dd] = MFMA32(vf[s2][dd], pb, o[dd]); }
    }
    const float inv = frcp(l);
#pragma unroll
    for (int dd = 0; dd < D / 32; ++dd)
#pragma unroll
        for (int g = 0; g < 4; ++g) { u32x2 w; w.x = pk2(o[dd][4 * g] * inv, o[dd][4 * g + 1] * inv); w.y = pk2(o[dd][4 * g + 2] * inv, o[dd][4 * g + 3] * inv); t.ostore(r, 32 * dd + 8 * g + 4 * h, w); }
}
DI void zero16(f32x16& s) {
#pragma unroll
    for (int i = 0; i < 16; ++i) s[i] = 0.f;
}
struct AttSwP {
    static constexpr int D = 64, NCH = 5; static constexpr bool VSPLIT = false;
    bf16_t* qo; const bf16_t* kb; const bf16_t* vb; int g; float slope2, sink2, lc; bool dry;
    DI AttSwP(bf16_t* proj, const bf16_t* vt, const bf16_t* ks, int b, int hd, int g_, float sl2, float sk2, bool dry_) {
        const int lane = threadIdx.x & 63, r = lane & 31, h = lane >> 5, bk = b * 2 + (hd >> 2);
        qo = proj + (size_t)(b * 4096 + 32 * g_ + r) * NPJ + C_SQ + hd * 64; kb = ks + (size_t)bk * (128 * 2048) + h * 256 + r * 8; vb = vt + (size_t)bk * (256 * 1024) + h * 512 + r * 8;
        g = g_; slope2 = sl2; sink2 = sk2; lc = sl2 * (float)(32 * g_ + r); dry = dry_; }
    DI bf16x8 qfrag(int, int d0) const { return *(const bf16x8*)(qo + d0); }
    DI float m_init(int) const { return sink2; }
    DI float l_init() const { return 1.0f; }
    DI int cbeg() const { return g < 4 ? 4 - g : 0; }
    DI int tile(int c) const { return g - 4 + c; }
    DI bf16x8 kfrag_t(int tl, int kk) const { return *(const bf16x8*)(kb + (size_t)tl * 2048 + kk * 512); }
    DI bf16x8 vfrag_t(int tl, int s2, int dd) const { return *(const bf16x8*)(vb + (size_t)tl * 2048 + s2 * 1024 + dd * 256); }
    DI void init_s(f32x16& s, int tl) const { const int h = (threadIdx.x & 63) >> 5; const float c0 = slope2 * (float)(32 * tl) - lc;
#pragma unroll
        for (int i = 0; i < 16; ++i) s[i] = slope2 * (float)crow(i, h) + c0; }
    DI void post_s(f32x16& s, int tl, int r, int h) const {
        if (tl == g - 4) {
#pragma unroll
            for (int i = 0; i < 16; ++i) s[i] = crow(i, h) > r ? s[i] : -INFINITY; }
        if (tl == g) {
#pragma unroll
            for (int i = 0; i < 16; ++i) s[i] = crow(i, h) <= r ? s[i] : -INFINITY; } }
    DI void ostore(int, int d, u32x2 w) const { if (!dry) *(u32x2*)(qo + d) = w; }
};
struct AttSwS {
    static constexpr int D = 64, NCH = 5; static constexpr bool VSPLIT = true;
    bf16_t* proj; const float* ck; const float* cv; const float* nk; const float* nv; const float* sinks; int b, kvh; bool dry;
    DI bf16x8 qfrag(int r, int d0) const { return *(const bf16x8*)(proj + (size_t)(MP + b * 8 + (r & 7)) * NPJ + C_SQ + (kvh * 4 + (r >> 3)) * 64 + d0); }
    DI float m_init(int r) const { return sinks[kvh * 4 + (r >> 3)] * LOG2E; }
    DI float l_init() const { return 1.0f; }
    DI int cbeg() const { return 0; }
    DI int tile(int c) const { return c; }
    DI const float* krow(const float* c, const float* n, int kk) const { kk = kk > 135 ? 135 : kk; return kk < 128 ? c + ((size_t)(b * 128 + kk) * 2 + kvh) * 64 : n + ((size_t)(b * 128 + kk - 8) * 2 + kvh) * 64; }
    DI bf16x8 kfrag_t(int tl, int kk) const { const int lane = threadIdx.x & 63; return ld8f_bf(krow(ck, nk, 32 * tl + (lane & 31)) + 16 * kk + 8 * (lane >> 5)); }
    DI bf16x8 vfrag_t(int tl, int s2, int dd) const { const int lane = threadIdx.x & 63, d = 32 * dd + (lane & 31), ka = 32 * tl + 16 * s2 + 4 * (lane >> 5); f32x4 a, c;
#pragma unroll
        for (int j = 0; j < 4; ++j) { a[j] = krow(cv, nv, ka + j)[d]; c[j] = krow(cv, nv, ka + 8 + j)[d]; }
        return __builtin_bit_cast(bf16x8, pack8(a, c)); }
    DI void init_s(f32x16& s, int) const { zero16(s); }
    DI void post_s(f32x16& s, int tl, int r, int h) const { const float sl = fexp2(-(float)(kvh * 4 + (r >> 3) + 1)) * LOG2E;
#pragma unroll
        for (int i = 0; i < 16; ++i) { const int dist = 128 + (r & 7) - (32 * tl + crow(i, h)); s[i] = (dist >= 0 && dist < 128) ? s[i] - sl * (float)dist : -INFINITY; } }
    DI void ostore(int r, int d, u32x2 w) const { if (!dry) *(u32x2*)(proj + (size_t)(MP + b * 8 + (r & 7)) * NPJ + C_SQ + (kvh * 4 + (r >> 3)) * 64 + d) = w; }
};
struct AttMemP {
    static constexpr int D = 128, NCH = 8; static constexpr bool VSPLIT = false;
    bf16_t* qo; const bf16_t* kb; const bf16_t* vb; bool dry;
    DI AttMemP(bf16_t* proj, const bf16_t* mk, const bf16_t* mvt, int b, int hd, int g, bool dry_) {
        const int lane = threadIdx.x & 63, r = lane & 31, h = lane >> 5, bh = b * 4 + hd;
        qo = proj + (size_t)(b * 4096 + 32 * g + r) * NPJ + C_MQ + hd * 128; kb = mk + (size_t)bh * (8 * 4096) + h * 256 + r * 8; vb = mvt + (size_t)bh * (16 * 2048) + h * 1024 + r * 8; dry = dry_; }
    DI bf16x8 qfrag(int, int d0) const { return *(const bf16x8*)(qo + d0); }
    DI float m_init(int) const { return -INFINITY; }
    DI float l_init() const { return 0.0f; }
    DI int cbeg() const { return 0; }
    DI int tile(int c) const { return c; }
    DI bf16x8 kfrag_t(int tl, int kk) const { return *(const bf16x8*)(kb + (size_t)tl * 4096 + kk * 512); }
    DI bf16x8 vfrag_t(int tl, int s2, int dd) const { return *(const bf16x8*)(vb + (size_t)tl * 4096 + s2 * 2048 + dd * 256); }
    DI void init_s(f32x16& s, int) const { zero16(s); }
    DI void post_s(f32x16&, int, int, int) const {}
    DI void ostore(int, int d, u32x2 w) const { if (!dry) *(u32x2*)(qo + d) = w; }
};
struct AttMemS {
    static constexpr int D = 128, NCH = 8; static constexpr bool VSPLIT = true;
    bf16_t* proj; const float* mk; const float* mv; int b, hd; bool dry;
    DI bf16x8 qfrag(int r, int d0) const { return *(const bf16x8*)(proj + (size_t)(MP + b * 8 + (r & 7)) * NPJ + C_MQ + hd * 128 + d0); }
    DI float m_init(int) const { return -INFINITY; }
    DI float l_init() const { return 0.0f; }
    DI int cbeg() const { return 0; }
    DI int tile(int c) const { return c; }
    DI bf16x8 kfrag_t(int tl, int kk) const { const int lane = threadIdx.x & 63; return ld8f_bf(mk + ((size_t)(b * 256 + 32 * tl + (lane & 31)) * 4 + hd) * 128 + 16 * kk + 8 * (lane >> 5)); }
    DI bf16x8 vfrag_t(int tl, int s2, int dd) const { const int lane = threadIdx.x & 63; const float* p = mv + ((size_t)(b * 256 + 32 * tl + 16 * s2 + 4 * (lane >> 5)) * 4 + hd) * 128 + 32 * dd + (lane & 31); f32x4 a, c;
#pragma unroll
        for (int j = 0; j < 4; ++j) { a[j] = __builtin_nontemporal_load(p + (size_t)j * 512); c[j] = __builtin_nontemporal_load(p + (size_t)(8 + j) * 512); }
        return __builtin_bit_cast(bf16x8, pack8(a, c)); }
    DI void init_s(f32x16& s, int) const { zero16(s); }
    DI void post_s(f32x16&, int, int, int) const {}
    DI void ostore(int r, int d, u32x2 w) const { if (r < 8 && !dry) *(u32x2*)(proj + (size_t)(MP + b * 8 + r) * NPJ + C_MQ + hd * 128 + d) = w; }
};

constexpr int HQ_OFF = 0, HK_OFF = 17408, HKT_OFF = 34816, HVT_OFF = 53248, HA_OFF = 71680, HD_OFF = 80896, HBP_OFF = 81408, HSS_OFF = 83456, HRS_OFF = 85504;
constexpr int HOB_OFF = 85760, OBP = 132;
constexpr int QP = 136, TP = 72;
template <bool OUT> DI void hgrn_item(LAS unsigned char* lds, bf16_t* proj, float* hst, float* hdv, const float* normw, int item, bool dry) {
    const int tid = threadIdx.x, lane = tid & 63, w = __builtin_amdgcn_readfirstlane(tid >> 6);
    const int b = item >> 6, h = (item >> 4) & 3, c = item & 15;
    const int d = tid & 127, tq = tid >> 7;
    LAS bf16_t* Qt = (LAS bf16_t*)(lds + HQ_OFF); LAS bf16_t* Kt = (LAS bf16_t*)(lds + HK_OFF); LAS bf16_t* KtT = (LAS bf16_t*)(lds + HKT_OFF);
    LAS bf16_t* VT = (LAS bf16_t*)(lds + HVT_OFF); LAS bf16_t* Ab = (LAS bf16_t*)(lds + HA_OFF);
    LAS float* Dv = (LAS float*)(lds + HD_OFF); LAS float* bpart = (LAS float*)(lds + HBP_OFF); LAS float* ssq = (LAS float*)(lds + HSS_OFF); LAS float* rsd = (LAS float*)(lds + HRS_OFF);
    const int e16 = lane & 15, rq = lane >> 4;
    f32x4 st[8];
    float* hs = hst + (size_t)item * 16384 + (size_t)(w * 8) * 256 + lane * 4;
    if (OUT) {
#pragma unroll
        for (int i = 0; i < 8; ++i) st[i] = *(const f32x4*)(hs + i * 256);
    } else {
#pragma unroll
        for (int i = 0; i < 8; ++i) st[i] = (f32x4){0.f, 0.f, 0.f, 0.f};
    }
    float btot = 0.f;
    unsigned rg[8], rqv[8], rvv[8];
#define HG_LOAD(SC) do { const size_t r0_ = (size_t)b * 4096 + c * 256 + (SC) * 64 + tq * 16; const bf16_t* pg_ = proj + r0_ * NPJ + h * 128 + d; \
        _Pragma("unroll") for (int i = 0; i < 8; ++i) { const bf16_t* p0_ = pg_ + (size_t)(2 * i) * NPJ; const bf16_t* p1_ = p0_ + NPJ; \
            rg[i] = (unsigned)p0_[C_HF] | ((unsigned)p1_[C_HF] << 16); rvv[i] = (unsigned)p0_[C_HI] | ((unsigned)p1_[C_HI] << 16); \
            if (OUT) rqv[i] = (unsigned)p0_[C_HQ] | ((unsigned)p1_[C_HQ] << 16); } } while (0)
    HG_LOAD(0);
#pragma unroll 1
    for (int sc = 0; sc < 4; ++sc) {
        const size_t row0 = (size_t)b * 4096 + c * 256 + sc * 64;
        float gl[16], qv[16];
#pragma unroll
        for (int i = 0; i < 8; ++i) { gl[2 * i] = bflo(rg[i]); gl[2 * i + 1] = bfhi(rg[i]); if (OUT) { qv[2 * i] = bflo(rqv[i]); qv[2 * i + 1] = bfhi(rqv[i]); } }
        *(LAS u32x4*)(VT + d * TP + tq * 16) = (u32x4){rvv[0], rvv[1], rvv[2], rvv[3]};
        *(LAS u32x4*)(VT + d * TP + tq * 16 + 8) = (u32x4){rvv[4], rvv[5], rvv[6], rvv[7]};
        if (sc < 3) HG_LOAD(sc + 1);
        float run = 0.f;
        float bl[16];
#pragma unroll
        for (int i = 0; i < 16; ++i) { run += gl[i]; bl[i] = run; }
        bpart[tq * 128 + d] = run;
        __syncthreads();
        float off = 0.f, tot = 0.f;
#pragma unroll
        for (int q = 0; q < 4; ++q) { const float p = bpart[q * 128 + d]; tot += p; if (q < tq) off += p; }
        btot += tot;
        if (tq == 0) Dv[d] = fexp(tot);
        {
            unsigned kk[8];
#pragma unroll
            for (int i = 0; i < 8; ++i) {
                const float b0 = off + bl[2 * i], b1 = off + bl[2 * i + 1];
                const float k0 = (1.0f - fexp(gl[2 * i])) * fexp(-b0), k1 = (1.0f - fexp(gl[2 * i + 1])) * fexp(-b1);
                kk[i] = pk2(k0, k1);
                if (OUT) { Kt[(tq * 16 + 2 * i) * QP + d] = (bf16_t)(kk[i] & 0xffffu); Kt[(tq * 16 + 2 * i + 1) * QP + d] = (bf16_t)(kk[i] >> 16);
                    Qt[(tq * 16 + 2 * i) * QP + d] = f2bf(qv[2 * i] * fexp(b0)); Qt[(tq * 16 + 2 * i + 1) * QP + d] = f2bf(qv[2 * i + 1] * fexp(b1)); }
            }
            *(LAS u32x4*)(KtT + d * TP + tq * 16) = (u32x4){kk[0], kk[1], kk[2], kk[3]};
            *(LAS u32x4*)(KtT + d * TP + tq * 16 + 8) = (u32x4){kk[4], kk[5], kk[6], kk[7]};
        }
        __syncthreads();
        f32x4 o[4];
        bf16x8 vfr[2];
#pragma unroll
        for (int ks = 0; ks < 2; ++ks) vfr[ks] = *(const LAS bf16x8*)(VT + (w * 16 + e16) * TP + 32 * ks + 8 * rq);
        if (OUT) {
#pragma unroll
            for (int u = 0; u < 2; ++u) { const int id = w + 8 * u, ti = id >> 2, sj = id & 3;
                f32x4 a = {0.f, 0.f, 0.f, 0.f};
                if (sj <= ti) {
#pragma unroll
                    for (int ks = 0; ks < 4; ++ks) { const bf16x8 qa = *(const LAS bf16x8*)(Qt + (16 * ti + e16) * QP + 32 * ks + 8 * rq), kb = *(const LAS bf16x8*)(Kt + (16 * sj + e16) * QP + 32 * ks + 8 * rq);
                        a = MFMA16(qa, kb, a); }
                }
#pragma unroll
                for (int r = 0; r < 4; ++r) { const int tt = 16 * ti + 4 * rq + r, ss = 16 * sj + e16; Ab[tt * TP + ss] = (sj <= ti && ss <= tt) ? f2bf(a[r]) : (bf16_t)0; }
            }
#pragma unroll
            for (int ti = 0; ti < 4; ++ti) { o[ti] = (f32x4){0.f, 0.f, 0.f, 0.f};
#pragma unroll
                for (int ks = 0; ks < 4; ++ks) { const LAS bf16_t* qp = Qt + (16 * ti + e16) * QP + 32 * ks + 4 * rq; const u32x2 q0 = *(const LAS u32x2*)qp, q1 = *(const LAS u32x2*)(qp + 16);
                    u32x4 qa = {q0.x, q0.y, q1.x, q1.y};
                    u32x4 sb; sb.x = pk2(st[2 * ks][0], st[2 * ks][1]); sb.y = pk2(st[2 * ks][2], st[2 * ks][3]); sb.z = pk2(st[2 * ks + 1][0], st[2 * ks + 1][1]); sb.w = pk2(st[2 * ks + 1][2], st[2 * ks + 1][3]);
                    o[ti] = MFMA16(__builtin_bit_cast(bf16x8, qa), __builtin_bit_cast(bf16x8, sb), o[ti]); } }
        }
#pragma unroll
        for (int dt = 0; dt < 8; ++dt) {
#pragma unroll
            for (int ks = 0; ks < 2; ++ks) { const bf16x8 ka = *(const LAS bf16x8*)(KtT + (16 * dt + e16) * TP + 32 * ks + 8 * rq); st[dt] = MFMA16(ka, vfr[ks], st[dt]); }
            const f32x4 dv = *(const LAS f32x4*)(Dv + 16 * dt + 4 * rq);
            st[dt] *= dv;
        }
        u32x4 gate8[2];
        if (OUT) {
#pragma unroll
            for (int j = 0; j < 2; ++j) { const int cch = tid + 512 * j; gate8[j] = *(const u32x4*)(proj + (row0 + (cch >> 4)) * NPJ + C_HG + h * 128 + 8 * (cch & 15)); }
        }
        __syncthreads();
        if (OUT) {
#pragma unroll
            for (int ti = 0; ti < 4; ++ti)
#pragma unroll
                for (int ks = 0; ks < 2; ++ks) if (2 * ks <= ti) { const bf16x8 aa = *(const LAS bf16x8*)(Ab + (16 * ti + e16) * TP + 32 * ks + 8 * rq); o[ti] = MFMA16(aa, vfr[ks], o[ti]); }
            LAS float* Ob = (LAS float*)(lds + HOB_OFF);
#pragma unroll
            for (int ti = 0; ti < 4; ++ti)
#pragma unroll
                for (int r = 0; r < 4; ++r) Ob[(16 * ti + 4 * rq + r) * OBP + w * 16 + e16] = o[ti][r];
            __syncthreads();
#pragma unroll
            for (int j = 0; j < 2; ++j) { const int cch = tid + 512 * j, tt = cch >> 4, e0 = 8 * (cch & 15);
                const f32x4 a0 = *(const LAS f32x4*)(Ob + tt * OBP + e0), a1 = *(const LAS f32x4*)(Ob + tt * OBP + e0 + 4);
                float q = (a0[0] * a0[0] + a0[1] * a0[1]) + (a0[2] * a0[2] + a0[3] * a0[3]) + (a1[0] * a1[0] + a1[1] * a1[1]) + (a1[2] * a1[2] + a1[3] * a1[3]);
                q += __shfl_xor(q, 1); q += __shfl_xor(q, 2); q += __shfl_xor(q, 4); q += __shfl_xor(q, 8);
                const float rs = __builtin_amdgcn_rsqf(q * (1.0f / 128.0f) + 1e-6f);
                const f32x4 n0 = *(const f32x4*)(normw + e0), n1 = *(const f32x4*)(normw + e0 + 4); const u32x4 g = gate8[j];
                f32x4 y0, y1;
                y0[0] = a0[0] * rs * n0[0] * bflo(g.x); y0[1] = a0[1] * rs * n0[1] * bfhi(g.x); y0[2] = a0[2] * rs * n0[2] * bflo(g.y); y0[3] = a0[3] * rs * n0[3] * bfhi(g.y);
                y1[0] = a1[0] * rs * n1[0] * bflo(g.z); y1[1] = a1[1] * rs * n1[1] * bfhi(g.z); y1[2] = a1[2] * rs * n1[2] * bflo(g.w); y1[3] = a1[3] * rs * n1[3] * bfhi(g.w);
                if (!dry) *(u32x4*)(proj + (row0 + tt) * NPJ + C_HQ + h * 128 + e0) = pack8(y0, y1); }
        }
    }
    if (!OUT) {
#pragma unroll
        for (int i = 0; i < 8; ++i) *(f32x4*)(hs + i * 256) = st[i];
        if (tq == 0) hdv[(size_t)item * 128 + d] = fexp(btot);
    }
}
DI void hgrn_scan(float* hst, const float* hdv, float* out, int gt, bool dry) {
    const int bh = gt >> 12, rem = gt & 4095, w = rem >> 9, tile = (rem >> 6) & 7, lane = rem & 63;
    const int d0 = 16 * tile + 4 * (lane >> 4), e = 16 * w + (lane & 15);
    f32x4 S = {0.f, 0.f, 0.f, 0.f};
#pragma unroll 4
    for (int c = 0; c < 16; ++c) { const int item = bh * 16 + c; float* p = hst + (size_t)item * 16384 + (size_t)(w * 8 + tile) * 256 + lane * 4;
        const f32x4 loc = *(const f32x4*)p; const f32x4 dv = *(const f32x4*)(hdv + (size_t)item * 128 + d0);
        if (!dry) *(f32x4*)p = S; S = dv * S + loc; }
#pragma unroll
    for (int r = 0; r < 4; ++r) out[O_SP + ((size_t)bh * 128 + d0 + r) * 128 + e] = S[r];
}
DI void hgrn_sample_item(LAS unsigned char* lds, bf16_t* proj, const float* state, float* out, const float* normw, int item, bool dry) {
    const int tid = threadIdx.x, lane = tid & 63, w = tid >> 6;
    const int b = item >> 2, h = item & 3, e = tid & 127, dq = tid >> 7;
    LAS float* F = (LAS float*)lds;
    LAS float* Kk = F + 1024;
    LAS float* Q = Kk + 1024;
    LAS float* V = Q + 1024;
    LAS float* OP = V + 1024;
    for (int i = tid; i < 1024; i += 512) { const int t = i >> 7, dd = i & 127; const bf16_t* pr = proj + (size_t)(MP + b * 8 + t) * NPJ + h * 128 + dd;
        const float f = fexp(bf2f(pr[C_HF])); F[i] = f; Kk[i] = 1.0f - f; Q[i] = bf2f(pr[C_HQ]); V[i] = bf2f(pr[C_HI]); }
    float S[32];
    const float* sp = state + ((size_t)(b * 4 + h) * 128 + dq * 32) * 128 + e;
#pragma unroll
    for (int i = 0; i < 32; ++i) S[i] = __builtin_nontemporal_load(sp + (size_t)i * 128);
    __syncthreads();
#pragma unroll 1
    for (int t = 0; t < 8; ++t) { const float v = V[t * 128 + e]; float op = 0.f;
#pragma unroll
        for (int i = 0; i < 32; ++i) { const int dd = dq * 32 + i; S[i] = F[t * 128 + dd] * S[i] + Kk[t * 128 + dd] * v; op += Q[t * 128 + dd] * S[i]; }
        OP[(t * 4 + dq) * 128 + e] = op; }
    float* so = out + O_SS + ((size_t)(b * 4 + h) * 128 + dq * 32) * 128 + e;
#pragma unroll
    for (int i = 0; i < 32; ++i) __builtin_nontemporal_store(S[i], so + (size_t)i * 128);
    __syncthreads();
    {
        const int t = w; float o0 = 0.f, o1 = 0.f;
#pragma unroll
        for (int q = 0; q < 4; ++q) { o0 += OP[(t * 4 + q) * 128 + lane]; o1 += OP[(t * 4 + q) * 128 + 64 + lane]; }
        float ss = o0 * o0 + o1 * o1;
#pragma unroll
        for (int x = 1; x < 64; x <<= 1) ss += __shfl_xor(ss, x);
        const float rs = __builtin_amdgcn_rsqf(ss * (1.0f / 128.0f) + 1e-6f);
        bf16_t* pr = proj + (size_t)(MP + b * 8 + t) * NPJ + h * 128;
        const float g0 = bf2f(pr[C_HG + lane]), g1 = bf2f(pr[C_HG + 64 + lane]);
        __syncthreads();
        if (!dry) { pr[C_HQ + lane] = f2bf(o0 * rs * normw[lane] * g0); pr[C_HQ + 64 + lane] = f2bf(o1 * rs * normw[64 + lane] * g1); }
    }
    __syncthreads();
}

DI float wave_sum(float v) {
#pragma unroll
    for (int o = 1; o < 64; o <<= 1) v += __shfl_xor(v, o);
    return v;
}
DI void transpose_item(const float* W, int K, int N, bf16_t* WT, int k0, int n0, int drow0, LAS float* scr, int lane) {
#pragma unroll 8
    for (int i = 0; i < 32; ++i) { const int kk = 2 * i + (lane >> 5); scr[kk * 33 + (lane & 31)] = __builtin_nontemporal_load(W + (size_t)(k0 + kk) * N + n0 + (lane & 31)); }
    asm volatile("s_waitcnt lgkmcnt(0)" ::: "memory");
    const int c = lane & 7;
#pragma unroll
    for (int j = 0; j < 4; ++j) { const int n = (lane >> 3) + 8 * j; const LAS float* s = scr + (8 * c) * 33 + n;
        u32x4 o; o.x = pk2(s[0 * 33], s[1 * 33]); o.y = pk2(s[2 * 33], s[3 * 33]); o.z = pk2(s[4 * 33], s[5 * 33]); o.w = pk2(s[6 * 33], s[7 * 33]);
        *(u32x4*)(WT + (size_t)(drow0 + n) * K + k0 + 8 * c) = o; }
    asm volatile("s_waitcnt lgkmcnt(0)" ::: "memory");
}
DI void ln_row_f32_to_bf16(const float* x, const float* w, const float* bb, bf16_t* o, int lane) {
    const f32x4* xr = (const f32x4*)x + lane; f32x4 v[4]; float s = 0.f;
#pragma unroll
    for (int j = 0; j < 4; ++j) { v[j] = __builtin_nontemporal_load(xr + 64 * j); s += (v[j][0] + v[j][1]) + (v[j][2] + v[j][3]); }
    const float mean = wave_sum(s) * (1.f / 1024.f); float s2 = 0.f;
#pragma unroll
    for (int j = 0; j < 4; ++j) { v[j] = v[j] - mean; s2 += (v[j][0] * v[j][0] + v[j][1] * v[j][1]) + (v[j][2] * v[j][2] + v[j][3] * v[j][3]); }
    const float rstd = __builtin_amdgcn_rsqf(wave_sum(s2) * (1.f / 1024.f) + 1e-5f);
#pragma unroll
    for (int j = 0; j < 4; ++j) { const f32x4 ww = ((const f32x4*)w)[64 * j + lane], bv = ((const f32x4*)bb)[64 * j + lane]; const f32x4 y = v[j] * rstd * ww + bv;
        u32x2 p; p.x = pk2(y[0], y[1]); p.y = pk2(y[2], y[3]); ((u32x2*)o)[64 * j + lane] = p; }
}
template <bool F32OUT> DI void ln_row_bf16(const bf16_t* z, const float* w, const float* bb, void* o, int lane) {
    float v[16]; float s = 0.f;
#pragma unroll
    for (int j = 0; j < 2; ++j) { const u32x4 p = *(const u32x4*)(z + 512 * j + 8 * lane);
        v[8 * j + 0] = bflo(p.x); v[8 * j + 1] = bfhi(p.x); v[8 * j + 2] = bflo(p.y); v[8 * j + 3] = bfhi(p.y); v[8 * j + 4] = bflo(p.z); v[8 * j + 5] = bfhi(p.z); v[8 * j + 6] = bflo(p.w); v[8 * j + 7] = bfhi(p.w); }
#pragma unroll
    for (int i = 0; i < 16; ++i) s += v[i];
    const float mean = wave_sum(s) * (1.f / 1024.f); float s2 = 0.f;
#pragma unroll
    for (int i = 0; i < 16; ++i) { v[i] -= mean; s2 += v[i] * v[i]; }
    const float rstd = __builtin_amdgcn_rsqf(wave_sum(s2) * (1.f / 1024.f) + 1e-5f);
#pragma unroll
    for (int j = 0; j < 2; ++j) { const int c = 512 * j + 8 * lane; const f32x4 w0 = *(const f32x4*)(w + c), w1 = *(const f32x4*)(w + c + 4), b0 = *(const f32x4*)(bb + c), b1 = *(const f32x4*)(bb + c + 4);
        f32x4 y0, y1;
#pragma unroll
        for (int i = 0; i < 4; ++i) { y0[i] = v[8 * j + i] * rstd * w0[i] + b0[i]; y1[i] = v[8 * j + 4 + i] * rstd * w1[i] + b1[i]; }
        if (F32OUT) { __builtin_nontemporal_store(y0, (f32x4*)((float*)o + c)); __builtin_nontemporal_store(y1, (f32x4*)((float*)o + c + 4)); }
        else *(u32x4*)((bf16_t*)o + c) = pack8(y0, y1); }
}

#define XB_TMO      128
#define XB_XCNT(j)  (256  + 64 * (j))
#define XB_XSUB(j)  (1280 + 64 * (j))
#define XB_XGEN(j)  (2304 + 64 * (j))
#define XB_TOP      3328
#define XB_TOPGEN   3392
#define XCD_BAR_WORDS 3456
#define XB_SPIN_CAP (1u << 18)

__device__ __forceinline__ unsigned xb_ld(unsigned* p)              { return __hip_atomic_load(p, __ATOMIC_RELAXED, __HIP_MEMORY_SCOPE_AGENT); }
__device__ __forceinline__ unsigned xb_add(unsigned* p, unsigned v) { return __hip_atomic_fetch_add(p, v, __ATOMIC_RELAXED, __HIP_MEMORY_SCOPE_AGENT); }
__device__ __forceinline__ unsigned xb_xcc_id() { return (unsigned)__builtin_amdgcn_s_getreg((3 << 11) | 20) & 0xFu; }
#define XB_SPIN(cond, bar) do { unsigned _sp = 0; while (cond) { __builtin_amdgcn_s_sleep(1); \
    if ((++_sp & 255u) == 0u) { if (xb_ld(&(bar)[XB_TMO])) break; if (_sp > XB_SPIN_CAP) { atomicAdd(&(bar)[XB_TMO], 1u); break; } } } } while (0)

struct XcdBarrier {
    unsigned* bar; unsigned x;
    volatile LAS unsigned* st;
};

__device__ __forceinline__ XcdBarrier xcd_barrier_post(unsigned* bar, volatile LAS unsigned* st) {
    XcdBarrier b; b.bar = bar; b.x = xb_xcc_id(); b.st = st;
    if (threadIdx.x == 0) (void)xb_add(&bar[XB_XCNT(b.x)], 1u);
    return b;
}
__device__ __forceinline__ void xcd_barrier_complete(unsigned* bar, unsigned x, unsigned& nloc, unsigned& nx) {
    const unsigned G = gridDim.x * gridDim.y * gridDim.z;
    unsigned sum, cnt, mine, sp = 0u;
    for (;;) {
        sum = 0u; cnt = 0u; mine = 0u;
#pragma unroll
        for (unsigned j = 0; j < 16; ++j) { const unsigned c = xb_ld(&bar[XB_XCNT(j)]); sum += c; cnt += (c > 0u) ? 1u : 0u; mine = (j == x) ? c : mine; }
        if (sum == G) break;
        __builtin_amdgcn_s_sleep(1);
        if ((++sp & 255u) == 0u) { if (xb_ld(&bar[XB_TMO])) break; if (sp > XB_SPIN_CAP) { atomicAdd(&bar[XB_TMO], 1u); break; } }
    }
    nloc = mine > 0u ? mine : 1u; nx = cnt > 0u ? cnt : 1u;
}

__device__ __forceinline__ void xcd_barrier(const XcdBarrier& b) {
    asm volatile("s_waitcnt vmcnt(0)" ::: "memory");
    __syncthreads();
    if (threadIdx.x == 0) {
        unsigned* bar = b.bar;
        __builtin_amdgcn_s_waitcnt(0);
        unsigned nloc = b.st[0], nx = b.st[1];
        if (nloc == 0u) { xcd_barrier_complete(bar, b.x, nloc, nx); b.st[0] = nloc; b.st[1] = nx; }
        const unsigned old = xb_add(&bar[XB_XSUB(b.x)], 1u);
        const unsigned gen = old / nloc;
        if (old + 1u == (gen + 1u) * nloc) {
            __builtin_amdgcn_fence(__ATOMIC_RELEASE, "agent");
            asm volatile("s_waitcnt vmcnt(0)" ::: "memory");
            const unsigned og = xb_add(&bar[XB_TOP], 1u);
            const unsigned tg = og / nx;
            if (og + 1u == (tg + 1u) * nx) xb_add(&bar[XB_TOPGEN], 1u);
            else XB_SPIN(xb_ld(&bar[XB_TOPGEN]) == tg, bar);
            __builtin_amdgcn_fence(__ATOMIC_ACQUIRE, "agent");
            xb_add(&bar[XB_XGEN(b.x)], 1u);
            asm volatile("s_waitcnt vmcnt(0)" ::: "memory");
        } else {
            XB_SPIN(xb_ld(&bar[XB_XGEN(b.x)]) == gen, bar);
            __builtin_amdgcn_fence(__ATOMIC_ACQUIRE, "agent");
            asm volatile("s_waitcnt vmcnt(0)" ::: "memory");
        }
    }
    __syncthreads();
}


DI void ln_row_sample(const bf16_t* hrow, const float* z0, const float* z1, const float* w, const float* bb, float* o, int lane) {
    float v[16]; float s = 0.f;
#pragma unroll
    for (int j = 0; j < 2; ++j) { const int c = 512 * j + 8 * lane; const u32x4 p = *(const u32x4*)(hrow + c);
        const f32x4 a0 = *(const f32x4*)(z0 + c), a1 = *(const f32x4*)(z0 + c + 4), b0 = *(const f32x4*)(z1 + c), b1 = *(const f32x4*)(z1 + c + 4);
        v[8 * j + 0] = ALPHA * bflo(p.x) + a0[0] + b0[0]; v[8 * j + 1] = ALPHA * bfhi(p.x) + a0[1] + b0[1]; v[8 * j + 2] = ALPHA * bflo(p.y) + a0[2] + b0[2]; v[8 * j + 3] = ALPHA * bfhi(p.y) + a0[3] + b0[3];
        v[8 * j + 4] = ALPHA * bflo(p.z) + a1[0] + b1[0]; v[8 * j + 5] = ALPHA * bfhi(p.z) + a1[1] + b1[1]; v[8 * j + 6] = ALPHA * bflo(p.w) + a1[2] + b1[2]; v[8 * j + 7] = ALPHA * bfhi(p.w) + a1[3] + b1[3]; }
#pragma unroll
    for (int i = 0; i < 16; ++i) s += v[i];
    const float mean = wave_sum(s) * (1.f / 1024.f); float s2 = 0.f;
#pragma unroll
    for (int i = 0; i < 16; ++i) { v[i] -= mean; s2 += v[i] * v[i]; }
    const float rstd = __builtin_amdgcn_rsqf(wave_sum(s2) * (1.f / 1024.f) + 1e-5f);
#pragma unroll
    for (int j = 0; j < 2; ++j) { const int c = 512 * j + 8 * lane; const f32x4 w0 = *(const f32x4*)(w + c), w1 = *(const f32x4*)(w + c + 4), b0 = *(const f32x4*)(bb + c), b1 = *(const f32x4*)(bb + c + 4);
        f32x4 y0, y1;
#pragma unroll
        for (int i = 0; i < 4; ++i) { y0[i] = v[8 * j + i] * rstd * w0[i] + b0[i]; y1[i] = v[8 * j + 4 + i] * rstd * w1[i] + b1[i]; }
        __builtin_nontemporal_store(y0, (f32x4*)(o + c)); __builtin_nontemporal_store(y1, (f32x4*)(o + c + 4)); }
}
constexpr int LDS_BYTES = 131072 + 1024;
__global__ void __launch_bounds__(512, 2) fwd_kernel(Params P) {
    extern __shared__ __attribute__((aligned(16))) unsigned char lds_raw[];
    LAS unsigned char* lds = (LAS unsigned char*)lds_raw;
    cg::grid_group grid = cg::this_grid();
    volatile LAS unsigned* bst = (volatile LAS unsigned*)(lds + 131072 + 512);
    if (threadIdx.x < 2) bst[threadIdx.x] = 0u;
    __syncthreads();
    XcdBarrier xbar = xcd_barrier_post((unsigned*)(P.ws + W_BAR), bst);
    const int tid = threadIdx.x, lane = tid & 63, wave = __builtin_amdgcn_readfirstlane(tid >> 6);
    const int G = gridDim.x, cu = blockIdx.x;
    const int gw = cu * 8 + wave, NGW = G * 8;
    unsigned char* sc = (unsigned char*)P.out;
    bf16_t* WT_IN = (bf16_t*)(sc + S_WTIN); bf16_t* WT_UP = (bf16_t*)(sc + S_WTUP); bf16_t* WT_O = (bf16_t*)(sc + S_WTO); bf16_t* WT_F1 = (bf16_t*)(sc + S_WTF1); bf16_t* WT_F2 = (bf16_t*)(sc + S_WTF2);
    bf16_t* XN = (bf16_t*)(sc + S_XN); bf16_t* MKB = (bf16_t*)(sc + S_MKB); bf16_t* MVT = (bf16_t*)(sc + S_MVT); bf16_t* VTSW = (bf16_t*)(sc + S_VTSW); bf16_t* KSW = (bf16_t*)(sc + S_KSW); float* LB = (float*)(sc + S_LB);
    bf16_t* PROJ = (bf16_t*)(P.ws + W_PROJ); float* HST = (float*)(P.ws + W_HST); float* HDV = (float*)(P.ws + W_HD);
    const int lo = P.ph_lo, hi = P.ph_hi;
#ifndef ATT_MASK
#define ATT_MASK 15
#endif
#ifndef PHASE_MASK
#define PHASE_MASK 0x1fff
#endif
#define IN(k) (((PHASE_MASK >> (k)) & 1) && lo <= (k) && (k) < hi)
#ifndef DUP_MASK
#define DUP_MASK 0
#endif
#ifndef PROBE_P8
#define PROBE_P8 0
#endif
#ifndef PROBE_P1
#define PROBE_P1 0
#endif
#ifndef ATT_DRY_MASK
#define ATT_DRY_MASK 31
#endif
#define REPS(k) for (int rep_ = 0, nrep_ = 1 + ((DUP_MASK >> (k)) & 1); rep_ < nrep_; ++rep_)
#define DRY (rep_ + 1 < nrep_)
#define SEAM(k) do { if (IN(k) && IN((k) + 1)) { if (P.ph_lo < 0) grid.sync(); else xcd_barrier(xbar); } } while (0)

    if (IN(0)) REPS(0) {
        LAS float* scr = (LAS float*)(lds + wave * 8704);
        constexpr int IT_IN = 16 * 200, IT_MKV = 16 * 32, IT_UP = 8 * 32, IT_O = 16 * 32, IT_F1 = 16 * 176, IT_F2 = 44 * 32;
        constexpr int NIT = IT_IN + IT_MKV + 3 * IT_UP + IT_O + IT_F1 + IT_F2;
        for (int it = gw; it < NIT; it += NGW) {
            int r = it;
            if (r < IT_IN) { const int kb = r / 200, nb = r % 200; transpose_item(P.in[I_WIN], 1024, 6400, WT_IN, 64 * kb, 32 * nb, 32 * nb, scr, lane); continue; } r -= IT_IN;
            if (r < IT_MKV) { const int kb = r / 32, nb = r % 32; transpose_item(P.in[I_WMKV], 1024, 1024, WT_IN, 64 * kb, 32 * nb, 6400 + 32 * nb, scr, lane); continue; } r -= IT_MKV;
            if (r < 3 * IT_UP) { const int k = r / IT_UP, q = r % IT_UP, kb = q / 32, nb = q % 32; transpose_item(P.in[I_WSW + k], 512, 1024, WT_UP + (size_t)k * 1024 * 512, 64 * kb, 32 * nb, 32 * nb, scr, lane); continue; } r -= 3 * IT_UP;
            if (r < IT_O) { const int kb = r / 32, nb = r % 32; transpose_item(P.in[I_WO], 1024, 1024, WT_O, 64 * kb, 32 * nb, 32 * nb, scr, lane); continue; } r -= IT_O;
            if (r < IT_F1) { const int kb = r / 176, nb = r % 176; const int n0 = 32 * nb; const int drow = n0 < DFF ? (n0 / 128) * 256 + (n0 % 128) : ((n0 - DFF) / 128) * 256 + 128 + ((n0 - DFF) % 128);
                transpose_item(P.in[I_WF1], 1024, 5632, WT_F1, 64 * kb, n0, drow, scr, lane); continue; } r -= IT_F1;
            { const int kb = r / 32, nb = r % 32; transpose_item(P.in[I_WF2], 2816, 1024, WT_F2, 64 * kb, 32 * nb, 32 * nb, scr, lane); }
        }
        for (int m = gw; m < MT; m += NGW) { const float* x = m < MP ? P.in[I_XP] + (size_t)m * 1024 : P.in[I_XS] + (size_t)(m - MP) * 1024; ln_row_f32_to_bf16(x, P.in[I_LN0W], P.in[I_LN0B], XN + (size_t)m * 1024, lane); }
        for (int m = gw; m < 2048; m += NGW) { const f32x4* xr = (const f32x4*)(P.in[I_MEM] + (size_t)m * 1024) + lane; u32x2* o = (u32x2*)(XN + (size_t)(MT + m) * 1024) + lane;
#pragma unroll
            for (int j = 0; j < 4; ++j) { const f32x4 v = __builtin_nontemporal_load(xr + 64 * j); u32x2 p; p.x = pk2(v[0], v[1]); p.y = pk2(v[2], v[3]); o[64 * j] = p; } }
        for (int i = cu * 512 + tid; i < 128 * 120 * 32; i += G * 512) { const int q = i & 31, j = (i >> 5) % 120, b = (i >> 5) / 120;
            const size_t src = ((size_t)(b * 128 + j + 8) * 128) + q * 4, dst = ((size_t)(b * 128 + j) * 128) + q * 4;
            *(f32x4*)(P.out + O_KWS + dst) = *(const f32x4*)(P.in[I_CK] + src); *(f32x4*)(P.out + O_VWS + dst) = *(const f32x4*)(P.in[I_CV] + src); }
        if (cu == 0) { const float a0 = P.in[I_LBND][tid], a1 = P.in[I_LBND][512 + tid]; LB[tid] = frcp(1.0f + fexp(a1 - a0)); }
    }
    SEAM(0);
    if (IN(1)) REPS(1) {
        SchedIn S{1024, 1024, G, cu, (const char*)XN, (const char*)WT_IN};
#if PROBE_P1 == 1
        if (DRY) { EpiNull E0; pg8::gemm_phase(lds, S, E0); } else
#elif PROBE_P1 == 2
        if (DRY) { EpiIn E0{PROJ, P.out, LB, MKB, MVT, VTSW, KSW, 1}; pg8::gemm_phase(lds, S, E0); } else
#endif
        { EpiIn E{PROJ, P.out, LB, MKB, MVT, VTSW, KSW, 0}; pg8::gemm_phase(lds, S, E); }
    }
    SEAM(1);
    LAS unsigned* qctr = (LAS unsigned*)(lds + 131072 + 528);
#define ATT_Q_RESET() do { __syncthreads(); if (tid == 0) *qctr = 0u; __syncthreads(); } while (0)
#define ATT_Q_NEXT() __builtin_amdgcn_readfirstlane(lane == 0 ? (int)__hip_atomic_fetch_add(qctr, 1u, __ATOMIC_RELAXED, __HIP_MEMORY_SCOPE_WORKGROUP) : 0)
    if (IN(2)) REPS(2) {
        for (int it = cu; it < 512; it += G) { hgrn_item<false>(lds, PROJ, HST, HDV, P.in[I_HNW], it, DRY); __syncthreads(); }
        for (int it = cu; it < 512; it += G) hgrn_sample_item(lds, PROJ, P.in[I_ST], P.out, P.in[I_HNW], it, DRY);
        ATT_Q_RESET();
        for (int it = ATT_Q_NEXT() * G + cu; it < 768; it = ATT_Q_NEXT() * G + cu) {
            if (it < 512) { AttMemS t{PROJ, P.in[I_CMK], P.in[I_CMV], it >> 2, it & 3, DRY}; attn_item(t); }
            else { const int r = it - 512; AttSwS t{PROJ, P.in[I_CK], P.in[I_CV], P.out + O_KWS, P.out + O_VWS, P.in[I_SINK], r >> 1, r & 1, DRY}; attn_item(t); }
        }
    }
    SEAM(2);
#define ATT_RUN(LO, HI, WS) do { const int ws_ = (WS), W_ = 240 * 16 + 16 * ws_, ns_ = cu < 16 ? ws_ : 16; ATT_Q_RESET(); \
        for (;;) { const int j_ = ATT_Q_NEXT(), q_ = j_ % ns_, it_ = (LO) + (j_ / ns_) * W_ + (cu < 16 ? 3840 + cu + 16 * q_ : (cu - 16) + 240 * q_); if (it_ >= (HI)) break; \
            if (it_ < 4096) { AttMemP t(PROJ, MKB, MVT, it_ >> 9, (it_ >> 7) & 3, it_ & 127, DRY); attn_item(t); } \
            else { const int r_ = it_ - 4096, hd_ = (r_ >> 7) & 7; AttSwP t(PROJ, VTSW, KSW, r_ >> 10, hd_, r_ & 127, fexp2(-(float)(hd_ + 1)) * LOG2E, P.in[I_SINK][hd_] * LOG2E, DRY); attn_item(t); } } } while (0)
    constexpr int ATT_SPLIT = 9000, ATT_TOTAL = 12288;
    if (IN(3)) REPS(3) {
        if (cu >= 16) for (int gt = (cu - 16) * 512 + tid; gt < 131072; gt += (G - 16) * 512) hgrn_scan(HST, HDV, P.out, gt, DRY);
        if (cu < 16) { SchedUpS S{512, NPJ, 128 + (cu >> 2), cu & 3, (const char*)PROJ, (const char*)WT_UP}; EpiUp E{PROJ, DRY}; pg8::gemm_phase(lds, S, E); }
        ATT_RUN(0, ATT_SPLIT, 1);
    }
    SEAM(3);
    if (IN(4)) REPS(4) {
        if (cu < 16) { SchedOne S{1024, NPJ, 128 + (cu >> 2), cu & 3, (const char*)(PROJ + C_MIX), (const char*)WT_O}; EpiRes E{PROJ, XN, 1024}; pg8::gemm_phase(lds, S, E); }
        ATT_RUN(ATT_SPLIT, ATT_TOTAL, 2);
    }
    SEAM(4);
    if (IN(5)) REPS(5) {
        for (int it = cu; it < 512; it += G) { hgrn_item<true>(lds, PROJ, HST, HDV, P.in[I_HNW], it, DRY); __syncthreads(); }
    }
    SEAM(5);
    if (IN(6)) REPS(6) { SchedUp S{512, NPJ, G, cu, (const char*)PROJ, (const char*)WT_UP}; EpiUp E{PROJ, DRY}; pg8::gemm_phase(lds, S, E); }
    SEAM(6);
    if (IN(7)) REPS(7) { SchedPlain S{1024, NPJ, G, cu, (const char*)(PROJ + C_MIX), (const char*)WT_O, 128, 4}; EpiRes E{PROJ, XN, 1024}; pg8::gemm_phase(lds, S, E); }
    SEAM(7);
    if (IN(8)) REPS(8) { for (int m = gw; m < MT; m += NGW) ln_row_bf16<false>(PROJ + (size_t)m * NPJ + C_Z, P.in[I_LN1W], P.in[I_LN1B], PROJ + (size_t)m * NPJ + C_H, lane); }
    SEAM(8);
    if (IN(9)) REPS(9) { SchedPlain S{1024, NPJ, G, cu, (const char*)(PROJ + C_H), (const char*)WT_F1, 132, 22};
#if PROBE_P8 == 1
        if (DRY) { EpiNull E0; pg8::gemm_phase(lds, S, E0); } else
#elif PROBE_P8 == 2
        if (DRY) { EpiGlu E0{PROJ, 1}; pg8::gemm_phase(lds, S, E0); } else
#endif
        { EpiGlu E{PROJ, 0}; pg8::gemm_phase(lds, S, E); } }
    SEAM(9);
    if (IN(10)) REPS(10) { SchedPlain S{2816, NPJ, G, cu, (const char*)(PROJ + C_ACT), (const char*)WT_F2, 128, 4}; EpiRes E{PROJ, PROJ + C_H, NPJ}; pg8::gemm_phase(lds, S, E); }
    SEAM(10);
    float* ZP = (float*)(P.ws + W_ZP);
    if (IN(11)) REPS(11) {
        if (cu < 32) { SchedHalfK S{1408, NPJ, 128 + (cu >> 3), (cu >> 1) & 3, cu & 1, (const char*)(PROJ + C_ACT), (const char*)WT_F2}; EpiPart E{ZP}; pg8::gemm_phase(lds, S, E); }
        else { for (int m = (cu - 32) * 8 + wave; m < MP; m += (G - 32) * 8) if (m < 7808 || m >= 9216) ln_row_bf16<true>(PROJ + (size_t)m * NPJ + C_Z, P.in[I_LN2W], P.in[I_LN2B], P.out + O_YP + (size_t)m * 1024, lane); }
    }
    SEAM(11);
    if (IN(12)) REPS(12) {
        for (int i = gw; i < 1408 + MS; i += NGW) {
            if (i < 1408) { const int m = 7808 + i; ln_row_bf16<true>(PROJ + (size_t)m * NPJ + C_Z, P.in[I_LN2W], P.in[I_LN2B], P.out + O_YP + (size_t)m * 1024, lane); }
            else { const int m = i - 1408; ln_row_sample(PROJ + (size_t)(MP + m) * NPJ + C_H, ZP + (size_t)m * 1024, ZP + (size_t)(1024 + m) * 1024, P.in[I_LN2W], P.in[I_LN2B], P.out + O_YS + (size_t)m * 1024, lane); }
        }
    }
}

#ifndef N_LAUNCH_MODE
#define N_LAUNCH_MODE 1
#endif
extern "C" void kernel_launch(void* const* d_in, const int* in_sizes, int n_in, void* d_out, int out_size, void* d_ws, size_t ws_size, hipStream_t stream) {
    static bool attr_done = false;
    if (!attr_done) { hipFuncSetAttribute((const void*)fwd_kernel, hipFuncAttributeMaxDynamicSharedMemorySize, LDS_BYTES); attr_done = true; }
    if (ws_size < W_END) { fprintf(stderr, "kernel_launch: workspace too small: %zu < %zu\n", ws_size, (size_t)W_END); }
    Params p{};
    for (int i = 0; i < 25; ++i) p.in[i] = (const float*)d_in[i];
    p.out = (float*)d_out; p.ws = (unsigned char*)d_ws;
    const int grid = 256;
#if N_LAUNCH_MODE == 1
    p.ph_lo = 0; p.ph_hi = 13;
    hipMemsetAsync((char*)d_ws + W_BAR, 0, 16384, stream);
    void* args[] = {&p};
    hipError_t e = hipLaunchCooperativeKernel((const void*)fwd_kernel, dim3(grid), dim3(512), args, LDS_BYTES, stream);
    if (e != hipSuccess) fprintf(stderr, "cooperative launch failed: %s\n", hipGetErrorString(e));
#else
    for (int ph = 0; ph < 13; ++ph) { p.ph_lo = ph; p.ph_hi = ph + 1; hipLaunchKernelGGL(fwd_kernel, dim3(grid), dim3(512), LDS_BYTES, stream, p); }
#endif
}
```

```cpp
#include <hip/hip_runtime.h>
#include <hip/hip_cooperative_groups.h>
#include <cstdio>
#include <cstdint>
namespace cg = cooperative_groups;

#define LAS __attribute__((address_space(3)))
typedef unsigned short bf16_t;
typedef short bf16x8 __attribute__((ext_vector_type(8)));
typedef short s16x4 __attribute__((ext_vector_type(4)));
typedef float f32x4 __attribute__((ext_vector_type(4)));
typedef float f32x2 __attribute__((ext_vector_type(2)));
typedef float f32x16 __attribute__((ext_vector_type(16)));
typedef unsigned u32x4 __attribute__((ext_vector_type(4)));
typedef unsigned u32x2 __attribute__((ext_vector_type(2)));
typedef __bf16 bfv2 __attribute__((ext_vector_type(2)));
#define DI __device__ __forceinline__

constexpr int DM = 1024, BATCH = 8, SEQ = 4096, DECB = 128, DECS = 8;
constexpr int MP = BATCH * SEQ, MS = DECB * DECS, MT = MP + MS;
constexpr int NPJ = 6400;
constexpr int C_SQ = 0, C_SK = 512, C_HQ = 768, C_HF = 1280, C_HI = 1792, C_HG = 2304, C_MQ = 2816, C_GL = 3328;
constexpr int C_MIX = 3328, C_Z = 0, C_H = 1024, C_ACT = 2048;
constexpr int DFF = 2816;
constexpr float ALPHA = 1.189207115f;
constexpr float LOG2E = 1.4426950408889634f;
constexpr size_t O_YP = 0, O_YS = 33554432, O_KWP = 34603008, O_VWP = 34734080, O_SP = 34865152, O_MKP = 35389440, O_MVP = 36438016,
                 O_KWS = 37486592, O_VWS = 39583744, O_SS = 41680896;
constexpr size_t S_WTIN = 0, S_WTMKV = 13107200, S_WTUP = 15204352, S_WTO = 18350080, S_WTF1 = 20447232, S_WTF2 = 31981568,
                 S_XN = 37748736, S_MKB = 111149056, S_MVT = 113246208, S_VTSW = 115343360, S_LB = 123731968, S_KSW = 123736064;
constexpr size_t W_PROJ = 0, W_HST = 432537600, W_HD = 466092032, W_BAR = 466354176, W_ZP = 466370560, W_END = 466370560 + 8388608;

DI unsigned pk2(float lo, float hi) { f32x2 v = {lo, hi}; bfv2 b = __builtin_convertvector(v, bfv2); return __builtin_bit_cast(unsigned, b); }
DI bf16_t f2bf(float x) { return (bf16_t)(pk2(x, 0.f) & 0xffffu); }
DI float bf2f(bf16_t b) { return __uint_as_float(((unsigned)b) << 16); }
DI float bflo(unsigned w) { return __uint_as_float(w << 16); }
DI float bfhi(unsigned w) { return __uint_as_float(w & 0xffff0000u); }
DI float fexp2(float x) { return __builtin_amdgcn_exp2f(x); }
DI float fexp(float x) { return __builtin_amdgcn_exp2f(x * LOG2E); }
DI float frcp(float x) { return __builtin_amdgcn_rcpf(x); }
DI float fsigmoid(float x) { return frcp(1.0f + fexp(-x)); }
DI float fsilu(float x) { return x * fsigmoid(x); }
DI float flog(float x) { return __builtin_amdgcn_logf(x) * 0.6931471805599453f; }
DI u32x4 pack8(f32x4 a, f32x4 b) { u32x4 w; w.x = pk2(a[0], a[1]); w.y = pk2(a[2], a[3]); w.z = pk2(b[0], b[1]); w.w = pk2(b[2], b[3]); return w; }
DI bf16x8 ld8f_bf(const float* p) { const f32x4 a = __builtin_nontemporal_load((const f32x4*)p), b = __builtin_nontemporal_load((const f32x4*)(p + 4));     return __builtin_bit_cast(bf16x8, pack8(a, b)); }

namespace pg8 {
constexpr int BM = 256, BK = 64, HALF = 128, HTB = HALF * BK * 2, STAGE_BYTES = 8 * HTB, NXCD = 8, WGM = 8;
__host__ __device__ __forceinline__ int lds_byte(int r, int c) { const int st = (r >> 4) * 2 + (c >> 5), rr = r & 15, cc = c & 31, ob = rr * 64 + cc * 2; return st * 1024 + (ob ^ (((ob >> 9) & 1) << 5)); }
__host__ __device__ __forceinline__ void stage_rc(int b, int& R, int& C) { const int st = b / 1024, sb = b % 1024, swz = sb ^ (((sb >> 9) & 1) << 5); R = (st >> 1) * 16 + swz / 64; C = (st & 1) * 32 + (swz % 64) / 2; }
__host__ __device__ __forceinline__ int perm32(int rho) { const int n = rho >> 4, i = rho & 15; return 8 * (i >> 2) + 4 * n + (i & 3); }
struct Unit { int pm, pn, k; };
DI void swz_tile(int L, int nM, int nN, int& pm, int& pn) {
    const int nwg = nM * nN; int wgid = L; { const int q = nwg / NXCD, r = nwg % NXCD, xcd = wgid % NXCD, off = wgid / NXCD; wgid = (xcd < r ? xcd * (q + 1) : r * (q + 1) + (xcd - r) * q) + off; }
    const int nig = WGM * nN, gid = wgid / nig, fm = gid * WGM, gsz = (nM - fm) < WGM ? (nM - fm) : WGM;
    pm = fm + ((wgid % nig) % gsz); pn = (wgid % nig) / gsz;
}
template <class Epi, class Sched>
DI void gemm_phase(LAS unsigned char* lds, const Sched& S, const Epi& E) {
    const int tid = threadIdx.x, wid = __builtin_amdgcn_readfirstlane(tid >> 6), lane = tid & 63, wr = wid >> 2, wc = wid & 3, fr = lane & 15, fq = lane >> 4;
    const int K = S.K, lda = S.lda, ldb = S.ldb(), nt = K / BK;
    unsigned voffA[2], voffB[2];
#pragma unroll
    for (int i = 0; i < 2; ++i) { int R, C; stage_rc(tid * 16 + i * 8192, R, C); const int Rb = (R & ~31) + perm32(R & 31);
        voffA[i] = (unsigned)(R * lda + C) * 2u; voffB[i] = (unsigned)(Rb * ldb + C) * 2u; }
    const size_t kstep = (size_t)(BK * 2);
    const size_t hstepA = (size_t)HALF * lda * 2, hstepB = (size_t)HALF * ldb * 2;
    const unsigned ldsw = (unsigned)wid * 1024u;
    const int aoff = lds_byte(wr * 64 + fr, fq * 8), boff = lds_byte(wc * 32 + fr, fq * 8);
#define PG8_SA(b, h) (((b) * 2 + (h)) * HTB)
#define PG8_SB(b, h) ((4 + (b) * 2 + (h)) * HTB)
#define PG8_STAGE(bufoff, gbase, voff) do { _Pragma("unroll") for (int _i = 0; _i < 2; ++_i) \
        __builtin_amdgcn_global_load_lds((const unsigned*)((const char*)(gbase) + (voff)[_i]), (LAS unsigned*)(lds + (bufoff) + ldsw + _i * 8192), 16, 0, 0); } while (0)
#define PG8_LDA(dst, b, h) do { _Pragma("unroll") for (int m = 0; m < 4; ++m) _Pragma("unroll") for (int k = 0; k < 2; ++k) dst[m][k] = *(const LAS bf16x8*)(lds + PG8_SA(b, h) + aoff + m * 2048 + k * 1024); } while (0)
#define PG8_LDB(dst, b, h) do { _Pragma("unroll") for (int n = 0; n < 2; ++n) _Pragma("unroll") for (int k = 0; k < 2; ++k) dst[n][k] = *(const LAS bf16x8*)(lds + PG8_SB(b, h) + boff + n * 2048 + k * 1024); } while (0)
#define PG8_MMA(ai, bj, At, Bt) do { __builtin_amdgcn_s_setprio(1); _Pragma("unroll") for (int m = 0; m < 4; ++m) _Pragma("unroll") for (int n = 0; n < 2; ++n) _Pragma("unroll") for (int k = 0; k < 2; ++k) \
        acc[ai][bj][m][n] = __builtin_amdgcn_mfma_f32_16x16x32_bf16(Bt[n][k], At[m][k], acc[ai][bj][m][n], 0, 0, 0); __builtin_amdgcn_s_setprio(0); } while (0)
#define PG8_WAIT_V(n) asm volatile("s_waitcnt vmcnt(" #n ")" ::: "memory")
#define PG8_WAIT_L(n) asm volatile("s_waitcnt lgkmcnt(" #n ")" ::: "memory")
#define PG8_BAR __builtin_amdgcn_s_barrier()
#define PG8_SCHED __builtin_amdgcn_sched_barrier(0)
    Unit cur, nxt; int ui = 0;
    if (!S.next(0, cur)) return;
    f32x4 acc[2][2][4][2];
#pragma unroll
    for (int a = 0; a < 2; ++a)
#pragma unroll
        for (int b = 0; b < 2; ++b)
#pragma unroll
            for (int m = 0; m < 4; ++m)
#pragma unroll
                for (int n = 0; n < 2; ++n) acc[a][b][m][n] = (f32x4){0.f, 0.f, 0.f, 0.f};
    bf16x8 At[4][2], B0[2][2], B1[2][2];
    const char* cA = S.pa(cur); const char* cB = S.pb(cur);
    PG8_STAGE(PG8_SB(0, 0), cB, voffB); PG8_STAGE(PG8_SB(0, 1), cB + hstepB, voffB); PG8_STAGE(PG8_SA(0, 0), cA, voffA); PG8_STAGE(PG8_SA(0, 1), cA + hstepA, voffA);
    if (wr == 1) PG8_BAR;
    PG8_WAIT_V(2); PG8_BAR;
    PG8_STAGE(PG8_SB(1, 0), cB + kstep, voffB); PG8_STAGE(PG8_SA(1, 0), cA + kstep, voffA); PG8_STAGE(PG8_SB(1, 1), cB + hstepB + kstep, voffB);
    PG8_WAIT_V(6); PG8_BAR;
    for (;;) {
        const bool has_next = S.next(ui + 1, nxt);
        const char* nA = has_next ? S.pa(nxt) : cA; const char* nB = has_next ? S.pb(nxt) : cB;
        for (int t = 0; t < nt; t += 2) {
            const bool last = (t == nt - 2);
            const char* a1 = cA + (size_t)(t + 1) * kstep;
            const char* a2 = last ? nA : cA + (size_t)(t + 2) * kstep; const char* b2 = last ? nB : cB + (size_t)(t + 2) * kstep;
            const char* a3 = a2 + kstep; const char* b3 = b2 + kstep;
            PG8_LDB(B0, 0, 0); PG8_LDB(B1, 0, 1); PG8_SCHED; PG8_LDA(At, 0, 0); PG8_STAGE(PG8_SA(1, 1), a1 + hstepA, voffA);
            PG8_WAIT_V(8); PG8_WAIT_L(0); PG8_BAR; PG8_MMA(0, 0, At, B0); PG8_MMA(0, 1, At, B1); PG8_BAR; PG8_SCHED;
            PG8_LDA(At, 0, 1); PG8_STAGE(PG8_SB(0, 0), b2, voffB); PG8_STAGE(PG8_SB(0, 1), b2 + hstepB, voffB); PG8_STAGE(PG8_SA(0, 0), a2, voffA);
            PG8_WAIT_V(8); PG8_WAIT_L(0); PG8_BAR; PG8_MMA(1, 0, At, B0); PG8_MMA(1, 1, At, B1); PG8_BAR; PG8_SCHED;
            PG8_LDB(B0, 1, 0); PG8_LDB(B1, 1, 1); PG8_SCHED; PG8_LDA(At, 1, 0); PG8_STAGE(PG8_SA(0, 1), a2 + hstepA, voffA);
            PG8_WAIT_V(8); PG8_WAIT_L(0); PG8_BAR; PG8_MMA(0, 0, At, B0); PG8_MMA(0, 1, At, B1); PG8_BAR; PG8_SCHED;
            PG8_LDA(At, 1, 1); PG8_STAGE(PG8_SB(1, 0), b3, voffB); PG8_STAGE(PG8_SB(1, 1), b3 + hstepB, voffB); PG8_STAGE(PG8_SA(1, 0), a3, voffA);
            PG8_WAIT_V(8); PG8_WAIT_L(0); PG8_BAR; PG8_MMA(1, 0, At, B0); PG8_MMA(1, 1, At, B1); PG8_BAR; PG8_SCHED;
        }
        if (wr == 0) PG8_BAR;
        E(acc, cur, wr, wc, fr, fq);
        if (!has_next) break;
#pragma unroll
        for (int a = 0; a < 2; ++a)
#pragma unroll
            for (int b = 0; b < 2; ++b)
#pragma unroll
                for (int m = 0; m < 4; ++m)
#pragma unroll
                    for (int n = 0; n < 2; ++n) acc[a][b][m][n] = (f32x4){0.f, 0.f, 0.f, 0.f};
        cur = nxt; cA = nA; cB = nB; ++ui;
        if (wr == 1) PG8_BAR;
    }
    PG8_WAIT_V(0);
    PG8_BAR;
#undef PG8_SA
#undef PG8_SB
#undef PG8_STAGE
#undef PG8_LDA
#undef PG8_LDB
#undef PG8_MMA
#undef PG8_WAIT_V
#undef PG8_WAIT_L
#undef PG8_BAR
#undef PG8_SCHED
}
}
using pg8::Unit;

struct Params {
    const float* in[25];
    float* out;
    unsigned char* ws;
    int ph_lo, ph_hi;
};
enum { I_XP = 0, I_XS, I_CK, I_CV, I_ST, I_CMK, I_CMV, I_MEM, I_LN0W, I_LN0B, I_WIN, I_WSW, I_WHG, I_WMX, I_SINK, I_LBND, I_HNW, I_WMKV, I_WO, I_LN1W, I_LN1B,
       I_WF1, I_WF2, I_LN2W, I_LN2B };

struct SchedIn {
    int K, lda, G, c; const char* A; const char* B;
    DI int ldb() const { return K; }
    DI bool next(int i, Unit& u) const { const int L = i * G + c; if (L >= 3332) return false;
        if (L < 3300) pg8::swz_tile(L, 132, 25, u.pm, u.pn); else { const int l = L - 3300; u.pm = 132 + (l >> 2); u.pn = 25 + (l & 3); } u.k = 0; return true; }
    DI const char* pa(const Unit& u) const { return A + (size_t)u.pm * (256 * 1024 * 2); }
    DI const char* pb(const Unit& u) const { return B + (size_t)u.pn * (256 * 1024 * 2); }
};
struct SchedUp {
    int K, lda, G, c; const char* A; const char* B;
    DI int ldb() const { return K; }
    DI bool next(int i, Unit& u) const { const int L = (i / 3) * G + c; if (L >= 512) return false; pg8::swz_tile(L, 128, 4, u.pm, u.pn); u.k = i % 3; return true; }
    DI const char* pa(const Unit& u) const { const int co = u.k == 0 ? C_SQ : (u.k == 1 ? C_HQ : C_MQ); return A + (size_t)u.pm * (256 * (size_t)NPJ * 2) + co * 2; }
    DI const char* pb(const Unit& u) const { return B + (size_t)(u.k * 1024 + u.pn * 256) * (512 * 2); }
};
struct SchedUpS {
    int K, lda, pm, pn; const char* A; const char* B;
    DI int ldb() const { return K; }
    DI bool next(int i, Unit& u) const { if (i >= 3) return false; u.pm = pm; u.pn = pn; u.k = i; return true; }
    DI const char* pa(const Unit& u) const { const int co = u.k == 0 ? C_SQ : (u.k == 1 ? C_HQ : C_MQ); return A + (size_t)u.pm * (256 * (size_t)NPJ * 2) + co * 2; }
    DI const char* pb(const Unit& u) const { return B + (size_t)(u.k * 1024 + u.pn * 256) * (512 * 2); }
};
struct SchedOne {
    int K, lda, pm, pn; const char* A; const char* B;
    DI int ldb() const { return K; }
    DI bool next(int i, Unit& u) const { if (i >= 1) return false; u.pm = pm; u.pn = pn; u.k = 0; return true; }
    DI const char* pa(const Unit& u) const { return A + (size_t)u.pm * (256 * (size_t)lda * 2); }
    DI const char* pb(const Unit& u) const { return B + (size_t)u.pn * (256 * (size_t)K * 2); }
};
struct SchedHalfK {
    int K, lda, pm, pn, half; const char* A; const char* B;
    DI int ldb() const { return DFF; }
    DI bool next(int i, Unit& u) const { if (i >= 1) return false; u.pm = pm; u.pn = pn; u.k = half; return true; }
    DI const char* pa(const Unit& u) const { return A + (size_t)u.pm * (256 * (size_t)lda * 2) + (size_t)half * (1408 * 2); }
    DI const char* pb(const Unit& u) const { return B + (size_t)u.pn * (256 * (size_t)DFF * 2) + (size_t)half * (1408 * 2); }
};
struct SchedPlain {
    int K, lda, G, c; const char* A; const char* B; int nM, nN;
    DI int ldb() const { return K; }
    DI bool next(int i, Unit& u) const { const int L = i * G + c; if (L >= nM * nN) return false; pg8::swz_tile(L, nM, nN, u.pm, u.pn); u.k = 0; return true; }
    DI const char* pa(const Unit& u) const { return A + (size_t)u.pm * (256 * (size_t)lda * 2); }
    DI const char* pb(const Unit& u) const { return B + (size_t)u.pn * (256 * (size_t)K * 2); }
};

typedef f32x4 Acc[2][2][4][2];
struct EpiIn {
    bf16_t* proj; float* out; const float* lb; bf16_t* mkb; bf16_t* mvt; bf16_t* vtsw; bf16_t* ksw; int mode;
    DI void operator()(Acc& acc, const Unit& u, int wr, int wc, int fr, int fq) const {
        asm volatile("" : "+v"(fr), "+v"(fq));
        const int pn = u.pn;
        f32x4 lbv[2][2];
        if (u.pm < 132 && (pn == 5 || pn == 6)) {
#pragma unroll
            for (int bj = 0; bj < 2; ++bj) { const int c = (pn - 5) * 256 + bj * 128 + wc * 32 + fq * 8; lbv[bj][0] = *(const f32x4*)(lb + c); lbv[bj][1] = *(const f32x4*)(lb + c + 4); }
        }
        if (u.pm >= 132) {
            const int b = u.pm - 132, kv = (pn - 25) >> 1;
#pragma unroll
            for (int ai = 0; ai < 2; ++ai)
#pragma unroll
                for (int m = 0; m < 4; ++m) { const int s = ai * 128 + wr * 64 + m * 16 + fr;
#pragma unroll
                    for (int bj = 0; bj < 2; ++bj) { const int h = 2 * ((pn - 25) & 1) + bj, d = wc * 32 + fq * 8;
                        const f32x4 v0 = acc[ai][bj][m][0], v1 = acc[ai][bj][m][1];
                        float* o = out + (kv ? O_MVP : O_MKP) + ((size_t)(b * 256 + s) * 4 + h) * 128 + d;
                        *(f32x4*)o = v0; *(f32x4*)(o + 4) = v1;
                        if (kv == 0) *(u32x4*)(mkb + ((((((size_t)(b * 4 + h) * 8 + (s >> 5)) * 8 + (d >> 4)) * 2 + ((d >> 3) & 1)) * 32 + (s & 31)) * 8)) = pack8(v0, v1);
                        else { const int w16 = s & 15; bf16_t* t = mvt + (((((size_t)(b * 4 + h) * 16 + (s >> 4)) * 2 + ((w16 >> 2) & 1)) * 128 + d) * 8) + (w16 & 3) + 4 * (w16 >> 3);
#pragma unroll
                            for (int j = 0; j < 4; ++j) { t[j * 8] = f2bf(v0[j]); t[(4 + j) * 8] = f2bf(v1[j]); } } } }
            return;
        }
#pragma unroll
        for (int ai = 0; ai < 2; ++ai)
#pragma unroll
            for (int m = 0; m < 4; ++m) { const int row = u.pm * 256 + ai * 128 + wr * 64 + m * 16 + fr;
                bf16_t* prow = proj + (size_t)row * NPJ + pn * 256 + wc * 32 + fq * 8;
#pragma unroll
                for (int bj = 0; bj < 2; ++bj) { f32x4 v0 = acc[ai][bj][m][0], v1 = acc[ai][bj][m][1];
                    if (pn == 2) {
                        const int kvh = wc >> 1, d = (wc & 1) * 32 + fq * 8;
                        float* o = nullptr;
                        if (row >= MP) { const int bs = (row - MP) >> 3, t = (row - MP) & 7; o = out + (bj ? O_VWS : O_KWS) + ((size_t)(bs * 128 + 120 + t) * 2 + kvh) * 64 + d; }
                        else { const int t = row & 4095; if (t >= 3968) o = out + (bj ? O_VWP : O_KWP) + ((size_t)((row >> 12) * 128 + t - 3968) * 2 + kvh) * 64 + d; }
                        if (o) { *(f32x4*)o = v0; *(f32x4*)(o + 4) = v1; }
                        if (row < MP) { const int tt = row & 4095, bk = ((row >> 12) * 2 + kvh);
                            if (bj == 0) *(u32x4*)(ksw + ((((((size_t)bk * 128 + (tt >> 5)) * 4 + (d >> 4)) * 2 + ((d >> 3) & 1)) * 32 + (tt & 31)) * 8)) = pack8(v0, v1);
                            else { const int w16 = tt & 15; bf16_t* t = vtsw + (((((size_t)bk * 256 + (tt >> 4)) * 2 + ((w16 >> 2) & 1)) * 64 + d) * 8) + (w16 & 3) + 4 * (w16 >> 3);
#pragma unroll
                                for (int j = 0; j < 4; ++j) { t[j * 8] = f2bf(v0[j]); t[(4 + j) * 8] = f2bf(v1[j]); } } }
                        continue;
                    }
                    if (pn < 2) { v0 *= 0.125f * LOG2E; v1 *= 0.125f * LOG2E; }
                    else if (pn < 5 || (pn >= 9 && pn < 11)) {
#pragma unroll
                        for (int j = 0; j < 4; ++j) { v0[j] = fsilu(v0[j]); v1[j] = fsilu(v1[j]); } }
                    else if (pn < 7) { const f32x4 l0 = lbv[bj][0], l1 = lbv[bj][1];
#pragma unroll
                        for (int j = 0; j < 4; ++j) { v0[j] = flog(l0[j] + (1.0f - l0[j]) * fsigmoid(v0[j])); v1[j] = flog(l1[j] + (1.0f - l1[j]) * fsigmoid(v1[j])); } }
                    else if (pn < 9) {}
                    else if (pn < 13) { v0 *= 0.08838834764831845f * LOG2E; v1 *= 0.08838834764831845f * LOG2E; }
                    else {
#pragma unroll
                        for (int j = 0; j < 4; ++j) { v0[j] = fsigmoid(v0[j]); v1[j] = fsigmoid(v1[j]); } }
                    const u32x4 w8 = pack8(v0, v1);
                    if (mode == 0) *(u32x4*)(prow + bj * 128) = w8; else asm volatile("" :: "v"(w8));
                } }
    }
};
struct EpiUp {
    bf16_t* proj; bool dry;
    DI void operator()(Acc& acc, const Unit& u, int wr, int wc, int fr, int fq) const {
        asm volatile("" : "+v"(fr), "+v"(fq));
        bf16_t* base = proj + (size_t)(u.pm * 256 + wr * 64 + fr) * NPJ + C_GL + u.pn * 256 + wc * 32 + fq * 8;
        {
            u32x4 g[2][4][2];
#pragma unroll
            for (int ai = 0; ai < 2; ++ai)
#pragma unroll
                for (int m = 0; m < 4; ++m)
#pragma unroll
                    for (int bj = 0; bj < 2; ++bj) g[ai][m][bj] = *(const u32x4*)(base + (size_t)(ai * 128 + m * 16) * NPJ + u.k * 1024 + bj * 128);
#pragma unroll
            for (int ai = 0; ai < 2; ++ai)
#pragma unroll
                for (int m = 0; m < 4; ++m)
#pragma unroll
                    for (int bj = 0; bj < 2; ++bj) { const u32x4 q = g[ai][m][bj]; f32x4& v0 = acc[ai][bj][m][0]; f32x4& v1 = acc[ai][bj][m][1];
                        v0[0] *= bflo(q.x); v0[1] *= bfhi(q.x); v0[2] *= bflo(q.y); v0[3] *= bfhi(q.y); v1[0] *= bflo(q.z); v1[1] *= bfhi(q.z); v1[2] *= bflo(q.w); v1[3] *= bfhi(q.w); }
        }
        if (u.k > 0) {
            u32x4 g[2][4][2];
#pragma unroll
            for (int ai = 0; ai < 2; ++ai)
#pragma unroll
                for (int m = 0; m < 4; ++m)
#pragma unroll
                    for (int bj = 0; bj < 2; ++bj) g[ai][m][bj] = *(const u32x4*)(base + (size_t)(ai * 128 + m * 16) * NPJ + bj * 128);
#pragma unroll
            for (int ai = 0; ai < 2; ++ai)
#pragma unroll
                for (int m = 0; m < 4; ++m)
#pragma unroll
                    for (int bj = 0; bj < 2; ++bj) { const u32x4 q = g[ai][m][bj]; f32x4& v0 = acc[ai][bj][m][0]; f32x4& v1 = acc[ai][bj][m][1];
                        v0[0] += bflo(q.x); v0[1] += bfhi(q.x); v0[2] += bflo(q.y); v0[3] += bfhi(q.y); v1[0] += bflo(q.z); v1[1] += bfhi(q.z); v1[2] += bflo(q.w); v1[3] += bfhi(q.w); }
        }
        if (!dry) {
#pragma unroll
            for (int ai = 0; ai < 2; ++ai)
#pragma unroll
                for (int m = 0; m < 4; ++m)
#pragma unroll
                    for (int bj = 0; bj < 2; ++bj) *(u32x4*)(base + (size_t)(ai * 128 + m * 16) * NPJ + bj * 128) = pack8(acc[ai][bj][m][0], acc[ai][bj][m][1]);
        }
    }
};
struct EpiRes {
    bf16_t* proj; const bf16_t* res; int rp;
    DI void operator()(Acc& acc, const Unit& u, int wr, int wc, int fr, int fq) const {
        asm volatile("" : "+v"(fr), "+v"(fq));
        const int row0 = u.pm * 256 + wr * 64 + fr, col0 = u.pn * 256 + wc * 32 + fq * 8;
        u32x4 g[2][4][2];
#pragma unroll
        for (int ai = 0; ai < 2; ++ai)
#pragma unroll
            for (int m = 0; m < 4; ++m)
#pragma unroll
                for (int bj = 0; bj < 2; ++bj) g[ai][m][bj] = *(const u32x4*)(res + (size_t)(row0 + ai * 128 + m * 16) * rp + col0 + bj * 128);
#pragma unroll
        for (int ai = 0; ai < 2; ++ai)
#pragma unroll
            for (int m = 0; m < 4; ++m)
#pragma unroll
                for (int bj = 0; bj < 2; ++bj) { const u32x4 p = g[ai][m][bj]; f32x4 v0 = acc[ai][bj][m][0], v1 = acc[ai][bj][m][1];
                    v0[0] += ALPHA * bflo(p.x); v0[1] += ALPHA * bfhi(p.x); v0[2] += ALPHA * bflo(p.y); v0[3] += ALPHA * bfhi(p.y);
                    v1[0] += ALPHA * bflo(p.z); v1[1] += ALPHA * bfhi(p.z); v1[2] += ALPHA * bflo(p.w); v1[3] += ALPHA * bfhi(p.w);
                    *(u32x4*)(proj + (size_t)(row0 + ai * 128 + m * 16) * NPJ + C_Z + col0 + bj * 128) = pack8(v0, v1); }
    }
};
struct EpiNull {
    DI void operator()(Acc& acc, const Unit& u, int wr, int wc, int fr, int fq) const {
#pragma unroll
        for (int ai = 0; ai < 2; ++ai)
#pragma unroll
            for (int bj = 0; bj < 2; ++bj)
#pragma unroll
                for (int m = 0; m < 4; ++m)
#pragma unroll
                    for (int n = 0; n < 2; ++n) asm volatile("" :: "v"(acc[ai][bj][m][n]));
    }
};
struct EpiPart {
    float* zp;
    DI void operator()(Acc& acc, const Unit& u, int wr, int wc, int fr, int fq) const {
        asm volatile("" : "+v"(fr), "+v"(fq));
#pragma unroll
        for (int ai = 0; ai < 2; ++ai)
#pragma unroll
            for (int m = 0; m < 4; ++m) { float* p = zp + ((size_t)u.k * 1024 + (size_t)(u.pm - 128) * 256 + ai * 128 + wr * 64 + m * 16 + fr) * 1024 + u.pn * 256 + wc * 32 + fq * 8;
#pragma unroll
                for (int bj = 0; bj < 2; ++bj) { *(f32x4*)(p + bj * 128) = acc[ai][bj][m][0]; *(f32x4*)(p + bj * 128 + 4) = acc[ai][bj][m][1]; } }
    }
};
struct EpiGlu {
    bf16_t* proj; int mode;
    DI void operator()(Acc& acc, const Unit& u, int wr, int wc, int fr, int fq) const {
        asm volatile("" : "+v"(fr), "+v"(fq));
#pragma unroll
        for (int ai = 0; ai < 2; ++ai)
#pragma unroll
            for (int m = 0; m < 4; ++m) { const int row = u.pm * 256 + ai * 128 + wr * 64 + m * 16 + fr;
                f32x4 v0, v1;
#pragma unroll
                for (int j = 0; j < 4; ++j) { v0[j] = fsilu(acc[ai][0][m][0][j]) * acc[ai][1][m][0][j]; v1[j] = fsilu(acc[ai][0][m][1][j]) * acc[ai][1][m][1][j]; }
                const u32x4 w8 = pack8(v0, v1);
                if (mode == 0) *(u32x4*)(proj + (size_t)row * NPJ + C_ACT + u.pn * 128 + wc * 32 + fq * 8) = w8; else asm volatile("" :: "v"(w8)); }
    }
};

DI int crow(int reg, int h) { return (reg & 3) + 8 * (reg >> 2) + 4 * h; }
DI bf16x8 pack_step(const f32x16& x, int s) { u32x4 p; p.x = pk2(x[8 * s], x[8 * s + 1]); p.y = pk2(x[8 * s + 2], x[8 * s + 3]); p.z = pk2(x[8 * s + 4], x[8 * s + 5]); p.w = pk2(x[8 * s + 6], x[8 * s + 7]); return __builtin_bit_cast(bf16x8, p); }
#define MFMA32(a, b, c) __builtin_amdgcn_mfma_f32_32x32x16_bf16((a), (b), (c), 0, 0, 0)
#define MFMA16(a, b, c) __builtin_amdgcn_mfma_f32_16x16x32_bf16((a), (b), (c), 0, 0, 0)

template <class T> DI void attn_item(const T& t) {
    constexpr int D = T::D, NCH = T::NCH;
    const int lane = threadIdx.x & 63, r = lane & 31, h = lane >> 5;
    bf16x8 qf[D / 16], kf[D / 16];
#pragma unroll
    for (int kk = 0; kk < D / 16; ++kk) qf[kk] = t.qfrag(r, 16 * kk + 8 * h);
    const int cbeg = t.cbeg();
    if (!T::VSPLIT) {
#pragma unroll
        for (int kk = 0; kk < D / 16; ++kk) kf[kk] = t.kfrag_t(t.tile(cbeg), kk);
    }
    float m = t.m_init(r), l = t.l_init();
    f32x16 o[D / 32];
#pragma unroll
    for (int dd = 0; dd < D / 32; ++dd)
#pragma unroll
        for (int i = 0; i < 16; ++i) o[dd][i] = 0.f;
    bf16x8 vf[2][D / 32];
#pragma unroll 1
    for (int c = cbeg; c < NCH; ++c) {
        const int tl = t.tile(c);
        if (!T::VSPLIT) {
#pragma unroll
            for (int s2 = 0; s2 < 2; ++s2)
#pragma unroll
                for (int dd = 0; dd < D / 32; ++dd) vf[s2][dd] = t.vfrag_t(tl, s2, dd);
        }
        f32x16 s;
        t.init_s(s, tl);
        if (T::VSPLIT) {
#pragma unroll
            for (int kk = 0; kk < D / 16; ++kk) kf[kk] = t.kfrag_t(tl, kk);
        }
#pragma unroll
        for (int kk = 0; kk < D / 16; ++kk) s = MFMA32(kf[kk], qf[kk], s);
        if (!T::VSPLIT && c + 1 < NCH) {
#pragma unroll
            for (int kk = 0; kk < D / 16; ++kk) kf[kk] = t.kfrag_t(tl + 1, kk); }
        t.post_s(s, tl, r, h);
        float mx = s[0];
#pragma unroll
        for (int i = 1; i < 16; ++i) mx = fmaxf(mx, s[i]);
        mx = fmaxf(mx, __shfl_xor(mx, 32));
        const bool need = mx > m + 8.0f;
        if (__builtin_amdgcn_ballot_w64(need) != 0ull) {
            const float mn = need ? mx : m;
            const float sc = fexp2(m - mn);
            l *= sc; m = mn;
#pragma unroll
            for (int dd = 0; dd < D / 32; ++dd)
#pragma unroll
                for (int i = 0; i < 16; ++i) o[dd][i] *= sc;
        }
        float ps = 0.f;
#pragma unroll
        for (int i = 0; i < 16; ++i) { const float p = fexp2(s[i] - m); s[i] = p; ps += p; }
        ps += __shfl_xor(ps, 32);
        l += ps;
#pragma unroll
        for (int s2 = 0; s2 < 2; ++s2) { const bf16x8 pb = pack_step(s, s2);
            if (T::VSPLIT) {
#pragma unroll
                for (int dd = 0; dd < D / 32; ++dd) vf[s2][dd] = t.vfrag_t(tl, s2, dd);
            }
#pragma unroll
            for (int dd = 0; dd < D / 32; ++dd) o[dd] = MFMA32(vf[s2][dd], pb, o[dd]); }
    }
    const float inv = frcp(l);
#pragma unroll
    for (int dd = 0; dd < D / 32; ++dd)
#pragma unroll
        for (int g = 0; g < 4; ++g) { u32x2 w; w.x = pk2(o[dd][4 * g] * inv, o[dd][4 * g + 1] * inv); w.y = pk2(o[dd][4 * g + 2] * inv, o[dd][4 * g + 3] * inv); t.ostore(r, 32 * dd + 8 * g + 4 * h, w); }
}
DI void zero16(f32x16& s) {
#pragma unroll
    for (int i = 0; i < 16; ++i) s[i] = 0.f;
}
struct AttSwP {
    static constexpr int D = 64, NCH = 5; static constexpr bool VSPLIT = false;
    bf16_t* qo; const bf16_t* kb; const bf16_t* vb; int g; float slope2, sink2, lc; bool dry;
    DI AttSwP(bf16_t* proj, const bf16_t* vt, const bf16_t* ks, int b, int hd, int g_, float sl2, float sk2, bool dry_) {
        const int lane = threadIdx.x & 63, r = lane & 31, h = lane >> 5, bk = b * 2 + (hd >> 2);
        qo = proj + (size_t)(b * 4096 + 32 * g_ + r) * NPJ + C_SQ + hd * 64; kb = ks + (size_t)bk * (128 * 2048) + h * 256 + r * 8; vb = vt + (size_t)bk * (256 * 1024) + h * 512 + r * 8;
        g = g_; slope2 = sl2; sink2 = sk2; lc = sl2 * (float)(32 * g_ + r); dry = dry_; }
    DI bf16x8 qfrag(int, int d0) const { return *(const bf16x8*)(qo + d0); }
    DI float m_init(int) const { return sink2; }
    DI float l_init() const { return 1.0f; }
    DI int cbeg() const { return g < 4 ? 4 - g : 0; }
    DI int tile(int c) const { return g - 4 + c; }
    DI bf16x8 kfrag_t(int tl, int kk) const { return *(const bf16x8*)(kb + (size_t)tl * 2048 + kk * 512); }
    DI bf16x8 vfrag_t(int tl, int s2, int dd) const { return *(const bf16x8*)(vb + (size_t)tl * 2048 + s2 * 1024 + dd * 256); }
    DI void init_s(f32x16& s, int tl) const { const int h = (threadIdx.x & 63) >> 5; const float c0 = slope2 * (float)(32 * tl) - lc;
#pragma unroll
        for (int i = 0; i < 16; ++i) s[i] = slope2 * (float)crow(i, h) + c0; }
    DI void post_s(f32x16& s, int tl, int r, int h) const {
        if (tl == g - 4) {
#pragma unroll
            for (int i = 0; i < 16; ++i) s[i] = crow(i, h) > r ? s[i] : -INFINITY; }
        if (tl == g) {
#pragma unroll
            for (int i = 0; i < 16; ++i) s[i] = crow(i, h) <= r ? s[i] : -INFINITY; } }
    DI void ostore(int, int d, u32x2 w) const { if (!dry) *(u32x2*)(qo + d) = w; }
};
struct AttSwS {
    static constexpr int D = 64, NCH = 5; static constexpr bool VSPLIT = true;
    bf16_t* proj; const float* ck; const float* cv; const float* nk; const float* nv; const float* sinks; int b, kvh; bool dry;
    DI bf16x8 qfrag(int r, int d0) const { return *(const bf16x8*)(proj + (size_t)(MP + b * 8 + (r & 7)) * NPJ + C_SQ + (kvh * 4 + (r >> 3)) * 64 + d0); }
    DI float m_init(int r) const { return sinks[kvh * 4 + (r >> 3)] * LOG2E; }
    DI float l_init() const { return 1.0f; }
    DI int cbeg() const { return 0; }
    DI int tile(int c) const { return c; }
    DI const float* krow(const float* c, const float* n, int kk) const { kk = kk > 135 ? 135 : kk; return kk < 128 ? c + ((size_t)(b * 128 + kk) * 2 + kvh) * 64 : n + ((size_t)(b * 128 + kk - 8) * 2 + kvh) * 64; }
    DI bf16x8 kfrag_t(int tl, int kk) const { const int lane = threadIdx.x & 63; return ld8f_bf(krow(ck, nk, 32 * tl + (lane & 31)) + 16 * kk + 8 * (lane >> 5)); }
    DI bf16x8 vfrag_t(int tl, int s2, int dd) const { const int lane = threadIdx.x & 63, d = 32 * dd + (lane & 31), ka = 32 * tl + 16 * s2 + 4 * (lane >> 5); f32x4 a, c;
#pragma unroll
        for (int j = 0; j < 4; ++j) { a[j] = krow(cv, nv, ka + j)[d]; c[j] = krow(cv, nv, ka + 8 + j)[d]; }
        return __builtin_bit_cast(bf16x8, pack8(a, c)); }
    DI void init_s(f32x16& s, int) const { zero16(s); }
    DI void post_s(f32x16& s, int tl, int r, int h) const { const float sl = fexp2(-(float)(kvh * 4 + (r >> 3) + 1)) * LOG2E;
#pragma unroll
        for (int i = 0; i < 16; ++i) { const int dist = 128 + (r & 7) - (32 * tl + crow(i, h)); s[i] = (dist >= 0 && dist < 128) ? s[i] - sl * (float)dist : -INFINITY; } }
    DI void ostore(int r, int d, u32x2 w) const { if (!dry) *(u32x2*)(proj + (size_t)(MP + b * 8 + (r & 7)) * NPJ + C_SQ + (kvh * 4 + (r >> 3)) * 64 + d) = w; }
};
struct AttMemP {
    static constexpr int D = 128, NCH = 8; static constexpr bool VSPLIT = false;
    bf16_t* qo; const bf16_t* kb; const bf16_t* vb; bool dry;
    DI AttMemP(bf16_t* proj, const bf16_t* mk, const bf16_t* mvt, int b, int hd, int g, bool dry_) {
        const int lane = threadIdx.x & 63, r = lane & 31, h = lane >> 5, bh = b * 4 + hd;
        qo = proj + (size_t)(b * 4096 + 32 * g + r) * NPJ + C_MQ + hd * 128; kb = mk + (size_t)bh * (8 * 4096) + h * 256 + r * 8; vb = mvt + (size_t)bh * (16 * 2048) + h * 1024 + r * 8; dry = dry_; }
    DI bf16x8 qfrag(int, int d0) const { return *(const bf16x8*)(qo + d0); }
    DI float m_init(int) const { return -INFINITY; }
    DI float l_init() const { return 0.0f; }
    DI int cbeg() const { return 0; }
    DI int tile(int c) const { return c; }
    DI bf16x8 kfrag_t(int tl, int kk) const { return *(const bf16x8*)(kb + (size_t)tl * 4096 + kk * 512); }
    DI bf16x8 vfrag_t(int tl, int s2, int dd) const { return *(const bf16x8*)(vb + (size_t)tl * 4096 + s2 * 2048 + dd * 256); }
    DI void init_s(f32x16& s, int) const { zero16(s); }
    DI void post_s(f32x16&, int, int, int) const {}
    DI void ostore(int, int d, u32x2 w) const { if (!dry) *(u32x2*)(qo + d) = w; }
};
struct AttMemS {
    static constexpr int D = 128, NCH = 8; static constexpr bool VSPLIT = true;
    bf16_t* proj; const float* mk; const float* mv; int b, hd; bool dry;
    DI bf16x8 qfrag(int r, int d0) const { return *(const bf16x8*)(proj + (size_t)(MP + b * 8 + (r & 7)) * NPJ + C_MQ + hd * 128 + d0); }
    DI float m_init(int) const { return -INFINITY; }
    DI float l_init() const { return 0.0f; }
    DI int cbeg() const { return 0; }
    DI int tile(int c) const { return c; }
    DI bf16x8 kfrag_t(int tl, int kk) const { const int lane = threadIdx.x & 63; return ld8f_bf(mk + ((size_t)(b * 256 + 32 * tl + (lane & 31)) * 4 + hd) * 128 + 16 * kk + 8 * (lane >> 5)); }
    DI bf16x8 vfrag_t(int tl, int s2, int dd) const { const int lane = threadIdx.x & 63; const float* p = mv + ((size_t)(b * 256 + 32 * tl + 16 * s2 + 4 * (lane >> 5)) * 4 + hd) * 128 + 32 * dd + (lane & 31); f32x4 a, c;
#pragma unroll
        for (int j = 0; j < 4; ++j) { a[j] = __builtin_nontemporal_load(p + (size_t)j * 512); c[j] = __builtin_nontemporal_load(p + (size_t)(8 + j) * 512); }
        return __builtin_bit_cast(bf16x8, pack8(a, c)); }
    DI void init_s(f32x16& s, int) const { zero16(s); }
    DI void post_s(f32x16&, int, int, int) const {}
    DI void ostore(int r, int d, u32x2 w) const { if (r < 8 && !dry) *(u32x2*)(proj + (size_t)(MP + b * 8 + r) * NPJ + C_MQ + hd * 128 + d) = w; }
};

constexpr int HQ_OFF = 0, HK_OFF = 17408, HKT_OFF = 34816, HVT_OFF = 53248, HA_OFF = 71680, HD_OFF = 80896, HBP_OFF = 81408, HSS_OFF = 83456, HRS_OFF = 85504;
constexpr int HOB_OFF = 85760, OBP = 132;
constexpr int QP = 136, TP = 72;
template <bool OUT> DI void hgrn_item(LAS unsigned char* lds, bf16_t* proj, float* hst, float* hdv, const float* normw, int item, bool dry) {
    const int tid = threadIdx.x, lane = tid & 63, w = __builtin_amdgcn_readfirstlane(tid >> 6);
    const int b = item >> 6, h = (item >> 4) & 3, c = item & 15;
    const int d = tid & 127, tq = tid >> 7;
    LAS bf16_t* Qt = (LAS bf16_t*)(lds + HQ_OFF); LAS bf16_t* Kt = (LAS bf16_t*)(lds + HK_OFF); LAS bf16_t* KtT = (LAS bf16_t*)(lds + HKT_OFF);
    LAS bf16_t* VT = (LAS bf16_t*)(lds + HVT_OFF); LAS bf16_t* Ab = (LAS bf16_t*)(lds + HA_OFF);
    LAS float* Dv = (LAS float*)(lds + HD_OFF); LAS float* bpart = (LAS float*)(lds + HBP_OFF); LAS float* ssq = (LAS float*)(lds + HSS_OFF); LAS float* rsd = (LAS float*)(lds + HRS_OFF);
    const int e16 = lane & 15, rq = lane >> 4;
    f32x4 st[8];
    float* hs = hst + (size_t)item * 16384 + (size_t)(w * 8) * 256 + lane * 4;
    if (OUT) {
#pragma unroll
        for (int i = 0; i < 8; ++i) st[i] = *(const f32x4*)(hs + i * 256);
    } else {
#pragma unroll
        for (int i = 0; i < 8; ++i) st[i] = (f32x4){0.f, 0.f, 0.f, 0.f};
    }
    float btot = 0.f;
    unsigned rg[8], rqv[8], rvv[8];
#define HG_LOAD(SC) do { const size_t r0_ = (size_t)b * 4096 + c * 256 + (SC) * 64 + tq * 16; const bf16_t* pg_ = proj + r0_ * NPJ + h * 128 + d; \
        _Pragma("unroll") for (int i = 0; i < 8; ++i) { const bf16_t* p0_ = pg_ + (size_t)(2 * i) * NPJ; const bf16_t* p1_ = p0_ + NPJ; \
            rg[i] = (unsigned)p0_[C_HF] | ((unsigned)p1_[C_HF] << 16); rvv[i] = (unsigned)p0_[C_HI] | ((unsigned)p1_[C_HI] << 16); \
            if (OUT) rqv[i] = (unsigned)p0_[C_HQ] | ((unsigned)p1_[C_HQ] << 16); } } while (0)
    HG_LOAD(0);
#pragma unroll 1
    for (int sc = 0; sc < 4; ++sc) {
        const size_t row0 = (size_t)b * 4096 + c * 256 + sc * 64;
        float gl[16], qv[16];
#pragma unroll
        for (int i = 0; i < 8; ++i) { gl[2 * i] = bflo(rg[i]); gl[2 * i + 1] = bfhi(rg[i]); if (OUT) { qv[2 * i] = bflo(rqv[i]); qv[2 * i + 1] = bfhi(rqv[i]); } }
        *(LAS u32x4*)(VT + d * TP + tq * 16) = (u32x4){rvv[0], rvv[1], rvv[2], rvv[3]};
        *(LAS u32x4*)(VT + d * TP + tq * 16 + 8) = (u32x4){rvv[4], rvv[5], rvv[6], rvv[7]};
        if (sc < 3) HG_LOAD(sc + 1);
        float run = 0.f;
        float bl[16];
#pragma unroll
        for (int i = 0; i < 16; ++i) { run += gl[i]; bl[i] = run; }
        bpart[tq * 128 + d] = run;
        __syncthreads();
        float off = 0.f, tot = 0.f;
#pragma unroll
        for (int q = 0; q < 4; ++q) { const float p = bpart[q * 128 + d]; tot += p; if (q < tq) off += p; }
        btot += tot;
        if (tq == 0) Dv[d] = fexp(tot);
        {
            unsigned kk[8];
#pragma unroll
            for (int i = 0; i < 8; ++i) {
                const float b0 = off + bl[2 * i], b1 = off + bl[2 * i + 1];
                const float k0 = (1.0f - fexp(gl[2 * i])) * fexp(-b0), k1 = (1.0f - fexp(gl[2 * i + 1])) * fexp(-b1);
                kk[i] = pk2(k0, k1);
                if (OUT) { Kt[(tq * 16 + 2 * i) * QP + d] = (bf16_t)(kk[i] & 0xffffu); Kt[(tq * 16 + 2 * i + 1) * QP + d] = (bf16_t)(kk[i] >> 16);
                    Qt[(tq * 16 + 2 * i) * QP + d] = f2bf(qv[2 * i] * fexp(b0)); Qt[(tq * 16 + 2 * i + 1) * QP + d] = f2bf(qv[2 * i + 1] * fexp(b1)); }
            }
            *(LAS u32x4*)(KtT + d * TP + tq * 16) = (u32x4){kk[0], kk[1], kk[2], kk[3]};
            *(LAS u32x4*)(KtT + d * TP + tq * 16 + 8) = (u32x4){kk[4], kk[5], kk[6], kk[7]};
        }
        __syncthreads();
        f32x4 o[4];
        bf16x8 vfr[2];
#pragma unroll
        for (int ks = 0; ks < 2; ++ks) vfr[ks] = *(const LAS bf16x8*)(VT + (w * 16 + e16) * TP + 32 * ks + 8 * rq);
        if (OUT) {
#pragma unroll
            for (int u = 0; u < 2; ++u) { const int id = w + 8 * u, ti = id >> 2, sj = id & 3;
                f32x4 a = {0.f, 0.f, 0.f, 0.f};
                if (sj <= ti) {
#pragma unroll
                    for (int ks = 0; ks < 4; ++ks) { const bf16x8 qa = *(const LAS bf16x8*)(Qt + (16 * ti + e16) * QP + 32 * ks + 8 * rq), kb = *(const LAS bf16x8*)(Kt + (16 * sj + e16) * QP + 32 * ks + 8 * rq);
                        a = MFMA16(qa, kb, a); }
                }
#pragma unroll
                for (int r = 0; r < 4; ++r) { const int tt = 16 * ti + 4 * rq + r, ss = 16 * sj + e16; Ab[tt * TP + ss] = (sj <= ti && ss <= tt) ? f2bf(a[r]) : (bf16_t)0; }
            }
#pragma unroll
            for (int ti = 0; ti < 4; ++ti) { o[ti] = (f32x4){0.f, 0.f, 0.f, 0.f};
#pragma unroll
                for (int ks = 0; ks < 4; ++ks) { const LAS bf16_t* qp = Qt + (16 * ti + e16) * QP + 32 * ks + 4 * rq; const u32x2 q0 = *(const LAS u32x2*)qp, q1 = *(const LAS u32x2*)(qp + 16);
                    u32x4 qa = {q0.x, q0.y, q1.x, q1.y};
                    u32x4 sb; sb.x = pk2(st[2 * ks][0], st[2 * ks][1]); sb.y = pk2(st[2 * ks][2], st[2 * ks][3]); sb.z = pk2(st[2 * ks + 1][0], st[2 * ks + 1][1]); sb.w = pk2(st[2 * ks + 1][2], st[2 * ks + 1][3]);
                    o[ti] = MFMA16(__builtin_bit_cast(bf16x8, qa), __builtin_bit_cast(bf16x8, sb), o[ti]); } }
        }
#pragma unroll
        for (int dt = 0; dt < 8; ++dt) {
#pragma unroll
            for (int ks = 0; ks < 2; ++ks) { const bf16x8 ka = *(const LAS bf16x8*)(KtT + (16 * dt + e16) * TP + 32 * ks + 8 * rq); st[dt] = MFMA16(ka, vfr[ks], st[dt]); }
            const f32x4 dv = *(const LAS f32x4*)(Dv + 16 * dt + 4 * rq);
            st[dt] *= dv;
        }
        u32x4 gate8[2];
        if (OUT) {
#pragma unroll
            for (int j = 0; j < 2; ++j) { const int cch = tid + 512 * j; gate8[j] = *(const u32x4*)(proj + (row0 + (cch >> 4)) * NPJ + C_HG + h * 128 + 8 * (cch & 15)); }
        }
        __syncthreads();
        if (OUT) {
#pragma unroll
            for (int ti = 0; ti < 4; ++ti)
#pragma unroll
                for (int ks = 0; ks < 2; ++ks) if (2 * ks <= ti) { const bf16x8 aa = *(const LAS bf16x8*)(Ab + (16 * ti + e16) * TP + 32 * ks + 8 * rq); o[ti] = MFMA16(aa, vfr[ks], o[ti]); }
            LAS float* Ob = (LAS float*)(lds + HOB_OFF);
#pragma unroll
            for (int ti = 0; ti < 4; ++ti)
#pragma unroll
                for (int r = 0; r < 4; ++r) Ob[(16 * ti + 4 * rq + r) * OBP + w * 16 + e16] = o[ti][r];
            __syncthreads();
#pragma unroll
            for (int j = 0; j < 2; ++j) { const int cch = tid + 512 * j, tt = cch >> 4, e0 = 8 * (cch & 15);
                const f32x4 a0 = *(const LAS f32x4*)(Ob + tt * OBP + e0), a1 = *(const LAS f32x4*)(Ob + tt * OBP + e0 + 4);
                float q = (a0[0] * a0[0] + a0[1] * a0[1]) + (a0[2] * a0[2] + a0[3] * a0[3]) + (a1[0] * a1[0] + a1[1] * a1[1]) + (a1[2] * a1[2] + a1[3] * a1[3]);
                q += __shfl_xor(q, 1); q += __shfl_xor(q, 2); q += __shfl_xor(q, 4); q += __shfl_xor(q, 8);
                const float rs = __builtin_amdgcn_rsqf(q * (1.0f / 128.0f) + 1e-6f);
                const f32x4 n0 = *(const f32x4*)(normw + e0), n1 = *(const f32x4*)(normw + e0 + 4); const u32x4 g = gate8[j];
                f32x4 y0, y1;
                y0[0] = a0[0] * rs * n0[0] * bflo(g.x); y0[1] = a0[1] * rs * n0[1] * bfhi(g.x); y0[2] = a0[2] * rs * n0[2] * bflo(g.y); y0[3] = a0[3] * rs * n0[3] * bfhi(g.y);
                y1[0] = a1[0] * rs * n1[0] * bflo(g.z); y1[1] = a1[1] * rs * n1[1] * bfhi(g.z); y1[2] = a1[2] * rs * n1[2] * bflo(g.w); y1[3] = a1[3] * rs * n1[3] * bfhi(g.w);
                if (!dry) *(u32x4*)(proj + (row0 + tt) * NPJ + C_HQ + h * 128 + e0) = pack8(y0, y1); }
        }
    }
    if (!OUT) {
#pragma unroll
        for (int i = 0; i < 8; ++i) *(f32x4*)(hs + i * 256) = st[i];
        if (tq == 0) hdv[(size_t)item * 128 + d] = fexp(btot);
    }
}
DI void hgrn_scan(float* hst, const float* hdv, float* out, int gt, bool dry) {
    const int bh = gt >> 12, rem = gt & 4095, w = rem >> 9, tile = (rem >> 6) & 7, lane = rem & 63;
    const int d0 = 16 * tile + 4 * (lane >> 4), e = 16 * w + (lane & 15);
    f32x4 S = {0.f, 0.f, 0.f, 0.f};
#pragma unroll 4
    for (int c = 0; c < 16; ++c) { const int item = bh * 16 + c; float* p = hst + (size_t)item * 16384 + (size_t)(w * 8 + tile) * 256 + lane * 4;
        const f32x4 loc = *(const f32x4*)p; const f32x4 dv = *(const f32x4*)(hdv + (size_t)item * 128 + d0);
        if (!dry) *(f32x4*)p = S; S = dv * S + loc; }
#pragma unroll
    for (int r = 0; r < 4; ++r) out[O_SP + ((size_t)bh * 128 + d0 + r) * 128 + e] = S[r];
}
DI void hgrn_sample_item(LAS unsigned char* lds, bf16_t* proj, const float* state, float* out, const float* normw, int item, bool dry) {
    const int tid = threadIdx.x, lane = tid & 63, w = tid >> 6;
    const int b = item >> 2, h = item & 3, e = tid & 127, dq = tid >> 7;
    LAS float* F = (LAS float*)lds;
    LAS float* Kk = F + 1024;
    LAS float* Q = Kk + 1024;
    LAS float* V = Q + 1024;
    LAS float* OP = V + 1024;
    for (int i = tid; i < 1024; i += 512) { const int t = i >> 7, dd = i & 127; const bf16_t* pr = proj + (size_t)(MP + b * 8 + t) * NPJ + h * 128 + dd;
        const float f = fexp(bf2f(pr[C_HF])); F[i] = f; Kk[i] = 1.0f - f; Q[i] = bf2f(pr[C_HQ]); V[i] = bf2f(pr[C_HI]); }
    float S[32];
    const float* sp = state + ((size_t)(b * 4 + h) * 128 + dq * 32) * 128 + e;
#pragma unroll
    for (int i = 0; i < 32; ++i) S[i] = __builtin_nontemporal_load(sp + (size_t)i * 128);
    __syncthreads();
#pragma unroll 1
    for (int t = 0; t < 8; ++t) { const float v = V[t * 128 + e]; float op = 0.f;
#pragma unroll
        for (int i = 0; i < 32; ++i) { const int dd = dq * 32 + i; S[i] = F[t * 128 + dd] * S[i] + Kk[t * 128 + dd] * v; op += Q[t * 128 + dd] * S[i]; }
        OP[(t * 4 + dq) * 128 + e] = op; }
    float* so = out + O_SS + ((size_t)(b * 4 + h) * 128 + dq * 32) * 128 + e;
#pragma unroll
    for (int i = 0; i < 32; ++i) __builtin_nontemporal_store(S[i], so + (size_t)i * 128);
    __syncthreads();
    {
        const int t = w; float o0 = 0.f, o1 = 0.f;
#pragma unroll
        for (int q = 0; q < 4; ++q) { o0 += OP[(t * 4 + q) * 128 + lane]; o1 += OP[(t * 4 + q) * 128 + 64 + lane]; }
        float ss = o0 * o0 + o1 * o1;
#pragma unroll
        for (int x = 1; x < 64; x <<= 1) ss += __shfl_xor(ss, x);
        const float rs = __builtin_amdgcn_rsqf(ss * (1.0f / 128.0f) + 1e-6f);
        bf16_t* pr = proj + (size_t)(MP + b * 8 + t) * NPJ + h * 128;
        const float g0 = bf2f(pr[C_HG + lane]), g1 = bf2f(pr[C_HG + 64 + lane]);
        __syncthreads();
        if (!dry) { pr[C_HQ + lane] = f2bf(o0 * rs * normw[lane] * g0); pr[C_HQ + 64 + lane] = f2bf(o1 * rs * normw[64 + lane] * g1); }
    }
    __syncthreads();
}

DI float wave_sum(float v) {
#pragma unroll
    for (int o = 1; o < 64; o <<= 1) v += __shfl_xor(v, o);
    return v;
}
DI void transpose_item(const float* W, int K, int N, bf16_t* WT, int k0, int n0, int drow0, LAS float* scr, int lane) {
#pragma unroll 8
    for (int i = 0; i < 32; ++i) { const int kk = 2 * i + (lane >> 5); scr[kk * 33 + (lane & 31)] = __builtin_nontemporal_load(W + (size_t)(k0 + kk) * N + n0 + (lane & 31)); }
    asm volatile("s_waitcnt lgkmcnt(0)" ::: "memory");
    const int c = lane & 7;
#pragma unroll
    for (int j = 0; j < 4; ++j) { const int n = (lane >> 3) + 8 * j; const LAS float* s = scr + (8 * c) * 33 + n;
        u32x4 o; o.x = pk2(s[0 * 33], s[1 * 33]); o.y = pk2(s[2 * 33], s[3 * 33]); o.z = pk2(s[4 * 33], s[5 * 33]); o.w = pk2(s[6 * 33], s[7 * 33]);
        *(u32x4*)(WT + (size_t)(drow0 + n) * K + k0 + 8 * c) = o; }
    asm volatile("s_waitcnt lgkmcnt(0)" ::: "memory");
}
DI void ln_row_f32_to_bf16(const float* x, const float* w, const float* bb, bf16_t* o, int lane) {
    const f32x4* xr = (const f32x4*)x + lane; f32x4 v[4]; float s = 0.f;
#pragma unroll
    for (int j = 0; j < 4; ++j) { v[j] = __builtin_nontemporal_load(xr + 64 * j); s += (v[j][0] + v[j][1]) + (v[j][2] + v[j][3]); }
    const float mean = wave_sum(s) * (1.f / 1024.f); float s2 = 0.f;
#pragma unroll
    for (int j = 0; j < 4; ++j) { v[j] = v[j] - mean; s2 += (v[j][0] * v[j][0] + v[j][1] * v[j][1]) + (v[j][2] * v[j][2] + v[j][3] * v[j][3]); }
    const float rstd = __builtin_amdgcn_rsqf(wave_sum(s2) * (1.f / 1024.f) + 1e-5f);
#pragma unroll
    for (int j = 0; j < 4; ++j) { const f32x4 ww = ((const f32x4*)w)[64 * j + lane], bv = ((const f32x4*)bb)[64 * j + lane]; const f32x4 y = v[j] * rstd * ww + bv;
        u32x2 p; p.x = pk2(y[0], y[1]); p.y = pk2(y[2], y[3]); ((u32x2*)o)[64 * j + lane] = p; }
}
template <bool F32OUT> DI void ln_row_bf16(const bf16_t* z, const float* w, const float* bb, void* o, int lane) {
    float v[16]; float s = 0.f;
#pragma unroll
    for (int j = 0; j < 2; ++j) { const u32x4 p = __builtin_nontemporal_load((const u32x4*)(z + 512 * j + 8 * lane));
        v[8 * j + 0] = bflo(p.x); v[8 * j + 1] = bfhi(p.x); v[8 * j + 2] = bflo(p.y); v[8 * j + 3] = bfhi(p.y); v[8 * j + 4] = bflo(p.z); v[8 * j + 5] = bfhi(p.z); v[8 * j + 6] = bflo(p.w); v[8 * j + 7] = bfhi(p.w); }
#pragma unroll
    for (int i = 0; i < 16; ++i) s += v[i];
    const float mean = wave_sum(s) * (1.f / 1024.f); float s2 = 0.f;
#pragma unroll
    for (int i = 0; i < 16; ++i) { v[i] -= mean; s2 += v[i] * v[i]; }
    const float rstd = __builtin_amdgcn_rsqf(wave_sum(s2) * (1.f / 1024.f) + 1e-5f);
#pragma unroll
    for (int j = 0; j < 2; ++j) { const int c = 512 * j + 8 * lane; const f32x4 w0 = *(const f32x4*)(w + c), w1 = *(const f32x4*)(w + c + 4), b0 = *(const f32x4*)(bb + c), b1 = *(const f32x4*)(bb + c + 4);
        f32x4 y0, y1;
#pragma unroll
        for (int i = 0; i < 4; ++i) { y0[i] = v[8 * j + i] * rstd * w0[i] + b0[i]; y1[i] = v[8 * j + 4 + i] * rstd * w1[i] + b1[i]; }
        if (F32OUT) { __builtin_nontemporal_store(y0, (f32x4*)((float*)o + c)); __builtin_nontemporal_store(y1, (f32x4*)((float*)o + c + 4)); }
        else *(u32x4*)((bf16_t*)o + c) = pack8(y0, y1); }
}

#define XB_TMO      128
#define XB_XCNT(j)  (256  + 64 * (j))
#define XB_XSUB(j)  (1280 + 64 * (j))
#define XB_XGEN(j)  (2304 + 64 * (j))
#define XB_TOP      3328
#define XB_TOPGEN   3392
#define XCD_BAR_WORDS 3456
#define XB_SPIN_CAP (1u << 18)

__device__ __forceinline__ unsigned xb_ld(unsigned* p)              { return __hip_atomic_load(p, __ATOMIC_RELAXED, __HIP_MEMORY_SCOPE_AGENT); }
__device__ __forceinline__ unsigned xb_add(unsigned* p, unsigned v) { return __hip_atomic_fetch_add(p, v, __ATOMIC_RELAXED, __HIP_MEMORY_SCOPE_AGENT); }
__device__ __forceinline__ unsigned xb_xcc_id() { return (unsigned)__builtin_amdgcn_s_getreg((3 << 11) | 20) & 0xFu; }
#define XB_SPIN(cond, bar) do { unsigned _sp = 0; while (cond) { __builtin_amdgcn_s_sleep(1); \
    if ((++_sp & 255u) == 0u) { if (xb_ld(&(bar)[XB_TMO])) break; if (_sp > XB_SPIN_CAP) { atomicAdd(&(bar)[XB_TMO], 1u); break; } } } } while (0)

struct XcdBarrier {
    unsigned* bar; unsigned x;
    volatile LAS unsigned* st;
};

__device__ __forceinline__ XcdBarrier xcd_barrier_post(unsigned* bar, volatile LAS unsigned* st) {
    XcdBarrier b; b.bar = bar; b.x = xb_xcc_id(); b.st = st;
    if (threadIdx.x == 0) (void)xb_add(&bar[XB_XCNT(b.x)], 1u);
    return b;
}
__device__ __forceinline__ void xcd_barrier_complete(unsigned* bar, unsigned x, unsigned& nloc, unsigned& nx) {
    const unsigned G = gridDim.x * gridDim.y * gridDim.z;
    unsigned sum, cnt, mine, sp = 0u;
    for (;;) {
        sum = 0u; cnt = 0u; mine = 0u;
#pragma unroll
        for (unsigned j = 0; j < 16; ++j) { const unsigned c = xb_ld(&bar[XB_XCNT(j)]); sum += c; cnt += (c > 0u) ? 1u : 0u; mine = (j == x) ? c : mine; }
        if (sum == G) break;
        __builtin_amdgcn_s_sleep(1);
        if ((++sp & 255u) == 0u) { if (xb_ld(&bar[XB_TMO])) break; if (sp > XB_SPIN_CAP) { atomicAdd(&bar[XB_TMO], 1u); break; } }
    }
    nloc = mine > 0u ? mine : 1u; nx = cnt > 0u ? cnt : 1u;
}

__device__ __forceinline__ void xcd_barrier(const XcdBarrier& b) {
    asm volatile("s_waitcnt vmcnt(0)" ::: "memory");
    __syncthreads();
    if (threadIdx.x == 0) {
        unsigned* bar = b.bar;
        __builtin_amdgcn_s_waitcnt(0);
        unsigned nloc = b.st[0], nx = b.st[1];
        if (nloc == 0u) { xcd_barrier_complete(bar, b.x, nloc, nx); b.st[0] = nloc; b.st[1] = nx; }
        const unsigned old = xb_add(&bar[XB_XSUB(b.x)], 1u);
        const unsigned gen = old / nloc;
        if (old + 1u == (gen + 1u) * nloc) {
            __builtin_amdgcn_fence(__ATOMIC_RELEASE, "agent");
            asm volatile("s_waitcnt vmcnt(0)" ::: "memory");
            const unsigned og = xb_add(&bar[XB_TOP], 1u);
            const unsigned tg = og / nx;
            if (og + 1u == (tg + 1u) * nx) xb_add(&bar[XB_TOPGEN], 1u);
            else XB_SPIN(xb_ld(&bar[XB_TOPGEN]) == tg, bar);
            __builtin_amdgcn_fence(__ATOMIC_ACQUIRE, "agent");
            xb_add(&bar[XB_XGEN(b.x)], 1u);
            asm volatile("s_waitcnt vmcnt(0)" ::: "memory");
        } else {
            XB_SPIN(xb_ld(&bar[XB_XGEN(b.x)]) == gen, bar);
            __builtin_amdgcn_fence(__ATOMIC_ACQUIRE, "agent");
            asm volatile("s_waitcnt vmcnt(0)" ::: "memory");
        }
    }
    __syncthreads();
}


DI void ln_row_sample(const bf16_t* hrow, const float* z0, const float* z1, const float* w, const float* bb, float* o, int lane) {
    float v[16]; float s = 0.f;
#pragma unroll
    for (int j = 0; j < 2; ++j) { const int c = 512 * j + 8 * lane; const u32x4 p = *(const u32x4*)(hrow + c);
        const f32x4 a0 = *(const f32x4*)(z0 + c), a1 = *(const f32x4*)(z0 + c + 4), b0 = *(const f32x4*)(z1 + c), b1 = *(const f32x4*)(z1 + c + 4);
        v[8 * j + 0] = ALPHA * bflo(p.x) + a0[0] + b0[0]; v[8 * j + 1] = ALPHA * bfhi(p.x) + a0[1] + b0[1]; v[8 * j + 2] = ALPHA * bflo(p.y) + a0[2] + b0[2]; v[8 * j + 3] = ALPHA * bfhi(p.y) + a0[3] + b0[3];
        v[8 * j + 4] = ALPHA * bflo(p.z) + a1[0] + b1[0]; v[8 * j + 5] = ALPHA * bfhi(p.z) + a1[1] + b1[1]; v[8 * j + 6] = ALPHA * bflo(p.w) + a1[2] + b1[2]; v[8 * j + 7] = ALPHA * bfhi(p.w) + a1[3] + b1[3]; }
#pragma unroll
    for (int i = 0; i < 16; ++i) s += v[i];
    const float mean = wave_sum(s) * (1.f / 1024.f); float s2 = 0.f;
#pragma unroll
    for (int i = 0; i < 16; ++i) { v[i] -= mean; s2 += v[i] * v[i]; }
    const float rstd = __builtin_amdgcn_rsqf(wave_sum(s2) * (1.f / 1024.f) + 1e-5f);
#pragma unroll
    for (int j = 0; j < 2; ++j) { const int c = 512 * j + 8 * lane; const f32x4 w0 = *(const f32x4*)(w + c), w1 = *(const f32x4*)(w + c + 4), b0 = *(const f32x4*)(bb + c), b1 = *(const f32x4*)(bb + c + 4);
        f32x4 y0, y1;
#pragma unroll
        for (int i = 0; i < 4; ++i) { y0[i] = v[8 * j + i] * rstd * w0[i] + b0[i]; y1[i] = v[8 * j + 4 + i] * rstd * w1[i] + b1[i]; }
        __builtin_nontemporal_store(y0, (f32x4*)(o + c)); __builtin_nontemporal_store(y1, (f32x4*)(o + c + 4)); }
}
constexpr int LDS_BYTES = 131072 + 1024;
__global__ void __launch_bounds__(512, 2) fwd_kernel(Params P) {
    extern __shared__ __attribute__((aligned(16))) unsigned char lds_raw[];
    LAS unsigned char* lds = (LAS unsigned char*)lds_raw;
    cg::grid_group grid = cg::this_grid();
    volatile LAS unsigned* bst = (volatile LAS unsigned*)(lds + 131072 + 512);
    if (threadIdx.x < 2) bst[threadIdx.x] = 0u;
    __syncthreads();
    XcdBarrier xbar = xcd_barrier_post((unsigned*)(P.ws + W_BAR), bst);
    const int tid = threadIdx.x, lane = tid & 63, wave = __builtin_amdgcn_readfirstlane(tid >> 6);
    const int G = gridDim.x, cu = blockIdx.x;
    const int gw = cu * 8 + wave, NGW = G * 8;
    unsigned char* sc = (unsigned char*)P.out;
    bf16_t* WT_IN = (bf16_t*)(sc + S_WTIN); bf16_t* WT_UP = (bf16_t*)(sc + S_WTUP); bf16_t* WT_O = (bf16_t*)(sc + S_WTO); bf16_t* WT_F1 = (bf16_t*)(sc + S_WTF1); bf16_t* WT_F2 = (bf16_t*)(sc + S_WTF2);
    bf16_t* XN = (bf16_t*)(sc + S_XN); bf16_t* MKB = (bf16_t*)(sc + S_MKB); bf16_t* MVT = (bf16_t*)(sc + S_MVT); bf16_t* VTSW = (bf16_t*)(sc + S_VTSW); bf16_t* KSW = (bf16_t*)(sc + S_KSW); float* LB = (float*)(sc + S_LB);
    bf16_t* PROJ = (bf16_t*)(P.ws + W_PROJ); float* HST = (float*)(P.ws + W_HST); float* HDV = (float*)(P.ws + W_HD);
    const int lo = P.ph_lo, hi = P.ph_hi;
#ifndef ATT_MASK
#define ATT_MASK 15
#endif
#ifndef PHASE_MASK
#define PHASE_MASK 0x1fff
#endif
#define IN(k) (((PHASE_MASK >> (k)) & 1) && lo <= (k) && (k) < hi)
#ifndef DUP_MASK
#define DUP_MASK 0
#endif
#ifndef PROBE_P8
#define PROBE_P8 0
#endif
#ifndef PROBE_P1
#define PROBE_P1 0
#endif
#ifndef ATT_DRY_MASK
#define ATT_DRY_MASK 31
#endif
#define REPS(k) for (int rep_ = 0, nrep_ = 1 + ((DUP_MASK >> (k)) & 1); rep_ < nrep_; ++rep_)
#define DRY (rep_ + 1 < nrep_)
#define SEAM(k) do { if (IN(k) && IN((k) + 1)) { if (P.ph_lo < 0) grid.sync(); else xcd_barrier(xbar); } } while (0)

    if (IN(0)) REPS(0) {
        LAS float* scr = (LAS float*)(lds + wave * 8704);
        constexpr int IT_IN = 16 * 200, IT_MKV = 16 * 32, IT_UP = 8 * 32, IT_O = 16 * 32, IT_F1 = 16 * 176, IT_F2 = 44 * 32;
        constexpr int NIT = IT_IN + IT_MKV + 3 * IT_UP + IT_O + IT_F1 + IT_F2;
        for (int it = gw; it < NIT; it += NGW) {
            int r = it;
            if (r < IT_IN) { const int kb = r / 200, nb = r % 200; transpose_item(P.in[I_WIN], 1024, 6400, WT_IN, 64 * kb, 32 * nb, 32 * nb, scr, lane); continue; } r -= IT_IN;
            if (r < IT_MKV) { const int kb = r / 32, nb = r % 32; transpose_item(P.in[I_WMKV], 1024, 1024, WT_IN, 64 * kb, 32 * nb, 6400 + 32 * nb, scr, lane); continue; } r -= IT_MKV;
            if (r < 3 * IT_UP) { const int k = r / IT_UP, q = r % IT_UP, kb = q / 32, nb = q % 32; transpose_item(P.in[I_WSW + k], 512, 1024, WT_UP + (size_t)k * 1024 * 512, 64 * kb, 32 * nb, 32 * nb, scr, lane); continue; } r -= 3 * IT_UP;
            if (r < IT_O) { const int kb = r / 32, nb = r % 32; transpose_item(P.in[I_WO], 1024, 1024, WT_O, 64 * kb, 32 * nb, 32 * nb, scr, lane); continue; } r -= IT_O;
            if (r < IT_F1) { const int kb = r / 176, nb = r % 176; const int n0 = 32 * nb; const int drow = n0 < DFF ? (n0 / 128) * 256 + (n0 % 128) : ((n0 - DFF) / 128) * 256 + 128 + ((n0 - DFF) % 128);
                transpose_item(P.in[I_WF1], 1024, 5632, WT_F1, 64 * kb, n0, drow, scr, lane); continue; } r -= IT_F1;
            { const int kb = r / 32, nb = r % 32; transpose_item(P.in[I_WF2], 2816, 1024, WT_F2, 64 * kb, 32 * nb, 32 * nb, scr, lane); }
        }
        for (int m = gw; m < MT; m += NGW) { const float* x = m < MP ? P.in[I_XP] + (size_t)m * 1024 : P.in[I_XS] + (size_t)(m - MP) * 1024; ln_row_f32_to_bf16(x, P.in[I_LN0W], P.in[I_LN0B], XN + (size_t)m * 1024, lane); }
        for (int m = gw; m < 2048; m += NGW) { const f32x4* xr = (const f32x4*)(P.in[I_MEM] + (size_t)m * 1024) + lane; u32x2* o = (u32x2*)(XN + (size_t)(MT + m) * 1024) + lane;
#pragma unroll
            for (int j = 0; j < 4; ++j) { const f32x4 v = __builtin_nontemporal_load(xr + 64 * j); u32x2 p; p.x = pk2(v[0], v[1]); p.y = pk2(v[2], v[3]); o[64 * j] = p; } }
        for (int i = cu * 512 + tid; i < 128 * 120 * 32; i += G * 512) { const int q = i & 31, j = (i >> 5) % 120, b = (i >> 5) / 120;
            const size_t src = ((size_t)(b * 128 + j + 8) * 128) + q * 4, dst = ((size_t)(b * 128 + j) * 128) + q * 4;
            *(f32x4*)(P.out + O_KWS + dst) = *(const f32x4*)(P.in[I_CK] + src); *(f32x4*)(P.out + O_VWS + dst) = *(const f32x4*)(P.in[I_CV] + src); }
        if (cu == 0) { const float a0 = P.in[I_LBND][tid], a1 = P.in[I_LBND][512 + tid]; LB[tid] = frcp(1.0f + fexp(a1 - a0)); }
    }
    SEAM(0);
    if (IN(1)) REPS(1) {
        SchedIn S{1024, 1024, G, cu, (const char*)XN, (const char*)WT_IN};
#if PROBE_P1 == 1
        if (DRY) { EpiNull E0; pg8::gemm_phase(lds, S, E0); } else
#elif PROBE_P1 == 2
        if (DRY) { EpiIn E0{PROJ, P.out, LB, MKB, MVT, VTSW, KSW, 1}; pg8::gemm_phase(lds, S, E0); } else
#endif
        { EpiIn E{PROJ, P.out, LB, MKB, MVT, VTSW, KSW, 0}; pg8::gemm_phase(lds, S, E); }
    }
    SEAM(1);
    LAS unsigned* qctr = (LAS unsigned*)(lds + 131072 + 528);
#define ATT_Q_RESET() do { __syncthreads(); if (tid == 0) *qctr = 0u; __syncthreads(); } while (0)
#define ATT_Q_NEXT() __builtin_amdgcn_readfirstlane(lane == 0 ? (int)__hip_atomic_fetch_add(qctr, 1u, __ATOMIC_RELAXED, __HIP_MEMORY_SCOPE_WORKGROUP) : 0)
    if (IN(2)) REPS(2) {
        for (int it = cu; it < 512; it += G) { hgrn_item<false>(lds, PROJ, HST, HDV, P.in[I_HNW], it, DRY); __syncthreads(); }
        for (int it = cu; it < 512; it += G) hgrn_sample_item(lds, PROJ, P.in[I_ST], P.out, P.in[I_HNW], it, DRY);
        ATT_Q_RESET();
        for (int it = ATT_Q_NEXT() * G + cu; it < 768; it = ATT_Q_NEXT() * G + cu) {
            if (it < 512) { AttMemS t{PROJ, P.in[I_CMK], P.in[I_CMV], it >> 2, it & 3, DRY}; attn_item(t); }
            else { const int r = it - 512; AttSwS t{PROJ, P.in[I_CK], P.in[I_CV], P.out + O_KWS, P.out + O_VWS, P.in[I_SINK], r >> 1, r & 1, DRY}; attn_item(t); }
        }
    }
    SEAM(2);
#define ATT_RUN(LO, HI, WS) do { const int ws_ = (WS), W_ = 240 * 16 + 16 * ws_, ns_ = cu < 16 ? ws_ : 16; ATT_Q_RESET(); \
        if (ns_ > 0) for (;;) { const int j_ = ATT_Q_NEXT(), q_ = j_ % ns_, it_ = (LO) + (j_ / ns_) * W_ + (cu < 16 ? 3840 + cu + 16 * q_ : (cu - 16) + 240 * q_); if (it_ >= (HI)) break; \
            if (it_ < 4096) { AttMemP t(PROJ, MKB, MVT, it_ >> 9, (it_ >> 7) & 3, it_ & 127, DRY); attn_item(t); } \
            else { const int r_ = it_ - 4096, hd_ = (r_ >> 7) & 7; AttSwP t(PROJ, VTSW, KSW, r_ >> 10, hd_, r_ & 127, fexp2(-(float)(hd_ + 1)) * LOG2E, P.in[I_SINK][hd_] * LOG2E, DRY); attn_item(t); } } } while (0)
    constexpr int ATT_SPLIT = 9000, ATT_TOTAL = 12288;
    if (IN(3)) REPS(3) {
        if (cu >= 16) for (int gt = (cu - 16) * 512 + tid; gt < 131072; gt += (G - 16) * 512) hgrn_scan(HST, HDV, P.out, gt, DRY);
        if (cu < 16) { SchedUpS S{512, NPJ, 128 + (cu >> 2), cu & 3, (const char*)PROJ, (const char*)WT_UP}; EpiUp E{PROJ, DRY}; pg8::gemm_phase(lds, S, E); }
        ATT_RUN(0, ATT_SPLIT, 0);
    }
    SEAM(3);
    if (IN(4)) REPS(4) {
        if (cu < 16) { SchedOne S{1024, NPJ, 128 + (cu >> 2), cu & 3, (const char*)(PROJ + C_MIX), (const char*)WT_O}; EpiRes E{PROJ, XN, 1024}; pg8::gemm_phase(lds, S, E); }
        ATT_RUN(ATT_SPLIT, ATT_TOTAL, 2);
    }
    SEAM(4);
    if (IN(5)) REPS(5) {
        for (int it = cu; it < 512; it += G) { hgrn_item<true>(lds, PROJ, HST, HDV, P.in[I_HNW], it, DRY); __syncthreads(); }
    }
    SEAM(5);
    if (IN(6)) REPS(6) { SchedUp S{512, NPJ, G, cu, (const char*)PROJ, (const char*)WT_UP}; EpiUp E{PROJ, DRY}; pg8::gemm_phase(lds, S, E); }
    SEAM(6);
    if (IN(7)) REPS(7) { SchedPlain S{1024, NPJ, G, cu, (const char*)(PROJ + C_MIX), (const char*)WT_O, 128, 4}; EpiRes E{PROJ, XN, 1024}; pg8::gemm_phase(lds, S, E); }
    SEAM(7);
    if (IN(8)) REPS(8) { for (int m = gw; m < MT; m += NGW) ln_row_bf16<false>(PROJ + (size_t)m * NPJ + C_Z, P.in[I_LN1W], P.in[I_LN1B], PROJ + (size_t)m * NPJ + C_H, lane); }
    SEAM(8);
    if (IN(9)) REPS(9) { SchedPlain S{1024, NPJ, G, cu, (const char*)(PROJ + C_H), (const char*)WT_F1, 132, 22};
#if PROBE_P8 == 1
        if (DRY) { EpiNull E0; pg8::gemm_phase(lds, S, E0); } else
#elif PROBE_P8 == 2
        if (DRY) { EpiGlu E0{PROJ, 1}; pg8::gemm_phase(lds, S, E0); } else
#endif
        { EpiGlu E{PROJ, 0}; pg8::gemm_phase(lds, S, E); } }
    SEAM(9);
    if (IN(10)) REPS(10) { SchedPlain S{2816, NPJ, G, cu, (const char*)(PROJ + C_ACT), (const char*)WT_F2, 128, 4}; EpiRes E{PROJ, PROJ + C_H, NPJ}; pg8::gemm_phase(lds, S, E); }
    SEAM(10);
    float* ZP = (float*)(P.ws + W_ZP);
    if (IN(11)) REPS(11) {
        if (cu < 32) { SchedHalfK S{1408, NPJ, 128 + (cu >> 3), (cu >> 1) & 3, cu & 1, (const char*)(PROJ + C_ACT), (const char*)WT_F2}; EpiPart E{ZP}; pg8::gemm_phase(lds, S, E); }
        else { for (int m = (cu - 32) * 8 + wave; m < MP; m += (G - 32) * 8) if (m < 7808 || m >= 9216) ln_row_bf16<true>(PROJ + (size_t)m * NPJ + C_Z, P.in[I_LN2W], P.in[I_LN2B], P.out + O_YP + (size_t)m * 1024, lane); }
    }
    SEAM(11);
    if (IN(12)) REPS(12) {
        for (int i = gw; i < 1408 + MS; i += NGW) {
            if (i < 1408) { const int m = 7808 + i; ln_row_bf16<true>(PROJ + (size_t)m * NPJ + C_Z, P.in[I_LN2W], P.in[I_LN2B], P.out + O_YP + (size_t)m * 1024, lane); }
            else { const int m = i - 1408; ln_row_sample(PROJ + (size_t)(MP + m) * NPJ + C_H, ZP + (size_t)m * 1024, ZP + (size_t)(1024 + m) * 1024, P.in[I_LN2W], P.in[I_LN2B], P.out + O_YS + (size_t)m * 1024, lane); }
        }
    }
}

#ifndef N_LAUNCH_MODE
#define N_LAUNCH_MODE 1
#endif
extern "C" void kernel_launch(void* const* d_in, const int* in_sizes, int n_in, void* d_out, int out_size, void* d_ws, size_t ws_size, hipStream_t stream) {
    static bool attr_done = false;
    if (!attr_done) { hipFuncSetAttribute((const void*)fwd_kernel, hipFuncAttributeMaxDynamicSharedMemorySize, LDS_BYTES); attr_done = true; }
    if (ws_size < W_END) { fprintf(stderr, "kernel_launch: workspace too small: %zu < %zu\n", ws_size, (size_t)W_END); }
    Params p{};
    for (int i = 0; i < 25; ++i) p.in[i] = (const float*)d_in[i];
    p.out = (float*)d_out; p.ws = (unsigned char*)d_ws;
    const int grid = 256;
#if N_LAUNCH_MODE == 1
    p.ph_lo = 0; p.ph_hi = 13;
    hipMemsetAsync((char*)d_ws + W_BAR, 0, 16384, stream);
    void* args[] = {&p};
    hipError_t e = hipLaunchCooperativeKernel((const void*)fwd_kernel, dim3(grid), dim3(512), args, LDS_BYTES, stream);
    if (e != hipSuccess) fprintf(stderr, "cooperative launch failed: %s\n", hipGetErrorString(e));
#else
    for (int ph = 0; ph < 13; ++ph) { p.ph_lo = ph; p.ph_hi = ph + 1; hipLaunchKernelGGL(fwd_kernel, dim3(grid), dim3(512), LDS_BYTES, stream, p); }
#endif
}
```

```cpp
#include <hip/hip_runtime.h>
#include <hip/hip_cooperative_groups.h>
#include <cstdio>
#include <cstdint>
namespace cg = cooperative_groups;

#define LAS __attribute__((address_space(3)))
typedef unsigned short bf16_t;
typedef short bf16x8 __attribute__((ext_vector_type(8)));
typedef short s16x4 __attribute__((ext_vector_type(4)));
typedef float f32x4 __attribute__((ext_vector_type(4)));
typedef float f32x2 __attribute__((ext_vector_type(2)));
typedef float f32x16 __attribute__((ext_vector_type(16)));
typedef unsigned u32x4 __attribute__((ext_vector_type(4)));
typedef unsigned u32x2 __attribute__((ext_vector_type(2)));
typedef __bf16 bfv2 __attribute__((ext_vector_type(2)));
#define DI __device__ __forceinline__

constexpr int DM = 1024, BATCH = 8, SEQ = 4096, DECB = 128, DECS = 8;
constexpr int MP = BATCH * SEQ, MS = DECB * DECS, MT = MP + MS;
constexpr int NPJ = 6400;
constexpr int C_SQ = 0, C_SK = 512, C_HQ = 768, C_HF = 1280, C_HI = 1792, C_HG = 2304, C_MQ = 2816, C_GL = 3328;
constexpr int C_MIX = 3328, C_Z = 0, C_H = 1024, C_ACT = 2048;
constexpr int DFF = 2816;
constexpr float ALPHA = 1.189207115f;
constexpr float LOG2E = 1.4426950408889634f;
constexpr size_t O_YP = 0, O_YS = 33554432, O_KWP = 34603008, O_VWP = 34734080, O_SP = 34865152, O_MKP = 35389440, O_MVP = 36438016,
                 O_KWS = 37486592, O_VWS = 39583744, O_SS = 41680896;
constexpr size_t S_WTIN = 0, S_WTMKV = 13107200, S_WTUP = 15204352, S_WTO = 18350080, S_WTF1 = 20447232, S_WTF2 = 31981568,
                 S_XN = 37748736, S_MKB = 111149056, S_MVT = 113246208, S_VTSW = 115343360, S_LB = 123731968, S_KSW = 123736064;
constexpr size_t W_PROJ = 0, W_HST = 432537600, W_HD = 466092032, W_BAR = 466354176, W_ZP = 466370560, W_END = 466370560 + 8388608;

DI unsigned pk2(float lo, float hi) { f32x2 v = {lo, hi}; bfv2 b = __builtin_convertvector(v, bfv2); return __builtin_bit_cast(unsigned, b); }
DI bf16_t f2bf(float x) { return (bf16_t)(pk2(x, 0.f) & 0xffffu); }
DI float bf2f(bf16_t b) { return __uint_as_float(((unsigned)b) << 16); }
DI float bflo(unsigned w) { return __uint_as_float(w << 16); }
DI float bfhi(unsigned w) { return __uint_as_float(w & 0xffff0000u); }
DI float fexp2(float x) { return __builtin_amdgcn_exp2f(x); }
DI float fexp(float x) { return __builtin_amdgcn_exp2f(x * LOG2E); }
DI float frcp(float x) { return __builtin_amdgcn_rcpf(x); }
DI float fsigmoid(float x) { return frcp(1.0f + fexp(-x)); }
DI float fsilu(float x) { return x * fsigmoid(x); }
DI float flog(float x) { return __builtin_amdgcn_logf(x) * 0.6931471805599453f; }
DI u32x4 pack8(f32x4 a, f32x4 b) { u32x4 w; w.x = pk2(a[0], a[1]); w.y = pk2(a[2], a[3]); w.z = pk2(b[0], b[1]); w.w = pk2(b[2], b[3]); return w; }
DI bf16x8 ld8f_bf(const float* p) { const f32x4 a = *(const f32x4*)p, b = *(const f32x4*)(p + 4); return __builtin_bit_cast(bf16x8, pack8(a, b)); }

namespace pg8 {
constexpr int BM = 256, BK = 64, HALF = 128, HTB = HALF * BK * 2, STAGE_BYTES = 8 * HTB, NXCD = 8, WGM = 8;
__host__ __device__ __forceinline__ int lds_byte(int r, int c) { const int st = (r >> 4) * 2 + (c >> 5), rr = r & 15, cc = c & 31, ob = rr * 64 + cc * 2; return st * 1024 + (ob ^ (((ob >> 9) & 1) << 5)); }
__host__ __device__ __forceinline__ void stage_rc(int b, int& R, int& C) { const int st = b / 1024, sb = b % 1024, swz = sb ^ (((sb >> 9) & 1) << 5); R = (st >> 1) * 16 + swz / 64; C = (st & 1) * 32 + (swz % 64) / 2; }
__host__ __device__ __forceinline__ int perm32(int rho) { const int n = rho >> 4, i = rho & 15; return 8 * (i >> 2) + 4 * n + (i & 3); }
struct Unit { int pm, pn, k; };
DI void swz_tile(int L, int nM, int nN, int& pm, int& pn) {
    const int nwg = nM * nN; int wgid = L; { const int q = nwg / NXCD, r = nwg % NXCD, xcd = wgid % NXCD, off = wgid / NXCD; wgid = (xcd < r ? xcd * (q + 1) : r * (q + 1) + (xcd - r) * q) + off; }
    const int nig = WGM * nN, gid = wgid / nig, fm = gid * WGM, gsz = (nM - fm) < WGM ? (nM - fm) : WGM;
    pm = fm + ((wgid % nig) % gsz); pn = (wgid % nig) / gsz;
}
template <class Epi, class Sched>
DI void gemm_phase(LAS unsigned char* lds, const Sched& S, const Epi& E) {
    const int tid = threadIdx.x, wid = __builtin_amdgcn_readfirstlane(tid >> 6), lane = tid & 63, wr = wid >> 2, wc = wid & 3, fr = lane & 15, fq = lane >> 4;
    const int K = S.K, lda = S.lda, ldb = S.ldb(), nt = K / BK;
    unsigned voffA[2], voffB[2];
#pragma unroll
    for (int i = 0; i < 2; ++i) { int R, C; stage_rc(tid * 16 + i * 8192, R, C); const int Rb = (R & ~31) + perm32(R & 31);
        voffA[i] = (unsigned)(R * lda + C) * 2u; voffB[i] = (unsigned)(Rb * ldb + C) * 2u; }
    const size_t kstep = (size_t)(BK * 2);
    const size_t hstepA = (size_t)HALF * lda * 2, hstepB = (size_t)HALF * ldb * 2;
    const unsigned ldsw = (unsigned)wid * 1024u;
    const int aoff = lds_byte(wr * 64 + fr, fq * 8), boff = lds_byte(wc * 32 + fr, fq * 8);
#define PG8_SA(b, h) (((b) * 2 + (h)) * HTB)
#define PG8_SB(b, h) ((4 + (b) * 2 + (h)) * HTB)
#define PG8_STAGE(bufoff, gbase, voff) do { _Pragma("unroll") for (int _i = 0; _i < 2; ++_i) \
        __builtin_amdgcn_global_load_lds((const unsigned*)((const char*)(gbase) + (voff)[_i]), (LAS unsigned*)(lds + (bufoff) + ldsw + _i * 8192), 16, 0, 0); } while (0)
#define PG8_LDA(dst, b, h) do { _Pragma("unroll") for (int m = 0; m < 4; ++m) _Pragma("unroll") for (int k = 0; k < 2; ++k) dst[m][k] = *(const LAS bf16x8*)(lds + PG8_SA(b, h) + aoff + m * 2048 + k * 1024); } while (0)
#define PG8_LDB(dst, b, h) do { _Pragma("unroll") for (int n = 0; n < 2; ++n) _Pragma("unroll") for (int k = 0; k < 2; ++k) dst[n][k] = *(const LAS bf16x8*)(lds + PG8_SB(b, h) + boff + n * 2048 + k * 1024); } while (0)
#define PG8_MMA(ai, bj, At, Bt) do { __builtin_amdgcn_s_setprio(1); _Pragma("unroll") for (int m = 0; m < 4; ++m) _Pragma("unroll") for (int n = 0; n < 2; ++n) _Pragma("unroll") for (int k = 0; k < 2; ++k) \
        acc[ai][bj][m][n] = __builtin_amdgcn_mfma_f32_16x16x32_bf16(Bt[n][k], At[m][k], acc[ai][bj][m][n], 0, 0, 0); __builtin_amdgcn_s_setprio(0); } while (0)
#define PG8_WAIT_V(n) asm volatile("s_waitcnt vmcnt(" #n ")" ::: "memory")
#define PG8_WAIT_L(n) asm volatile("s_waitcnt lgkmcnt(" #n ")" ::: "memory")
#define PG8_BAR __builtin_amdgcn_s_barrier()
#define PG8_SCHED __builtin_amdgcn_sched_barrier(0)
    Unit cur, nxt; int ui = 0;
    if (!S.next(0, cur)) return;
    f32x4 acc[2][2][4][2];
#pragma unroll
    for (int a = 0; a < 2; ++a)
#pragma unroll
        for (int b = 0; b < 2; ++b)
#pragma unroll
            for (int m = 0; m < 4; ++m)
#pragma unroll
                for (int n = 0; n < 2; ++n) acc[a][b][m][n] = (f32x4){0.f, 0.f, 0.f, 0.f};
    bf16x8 At[4][2], B0[2][2], B1[2][2];
    const char* cA = S.pa(cur); const char* cB = S.pb(cur);
    PG8_STAGE(PG8_SB(0, 0), cB, voffB); PG8_STAGE(PG8_SB(0, 1), cB + hstepB, voffB); PG8_STAGE(PG8_SA(0, 0), cA, voffA); PG8_STAGE(PG8_SA(0, 1), cA + hstepA, voffA);
    if (wr == 1) PG8_BAR;
    PG8_WAIT_V(2); PG8_BAR;
    PG8_STAGE(PG8_SB(1, 0), cB + kstep, voffB); PG8_STAGE(PG8_SA(1, 0), cA + kstep, voffA); PG8_STAGE(PG8_SB(1, 1), cB + hstepB + kstep, voffB);
    PG8_WAIT_V(6); PG8_BAR;
    for (;;) {
        const bool has_next = S.next(ui + 1, nxt);
        const char* nA = has_next ? S.pa(nxt) : cA; const char* nB = has_next ? S.pb(nxt) : cB;
        for (int t = 0; t < nt; t += 2) {
            const bool last = (t == nt - 2);
            const char* a1 = cA + (size_t)(t + 1) * kstep;
            const char* a2 = last ? nA : cA + (size_t)(t + 2) * kstep; const char* b2 = last ? nB : cB + (size_t)(t + 2) * kstep;
            const char* a3 = a2 + kstep; const char* b3 = b2 + kstep;
            PG8_LDB(B0, 0, 0); PG8_LDB(B1, 0, 1); PG8_SCHED; PG8_LDA(At, 0, 0); PG8_STAGE(PG8_SA(1, 1), a1 + hstepA, voffA);
            PG8_WAIT_V(8); PG8_WAIT_L(0); PG8_BAR; PG8_MMA(0, 0, At, B0); PG8_MMA(0, 1, At, B1); PG8_BAR; PG8_SCHED;
            PG8_LDA(At, 0, 1); PG8_STAGE(PG8_SB(0, 0), b2, voffB); PG8_STAGE(PG8_SB(0, 1), b2 + hstepB, voffB); PG8_STAGE(PG8_SA(0, 0), a2, voffA);
            PG8_WAIT_V(8); PG8_WAIT_L(0); PG8_BAR; PG8_MMA(1, 0, At, B0); PG8_MMA(1, 1, At, B1); PG8_BAR; PG8_SCHED;
            PG8_LDB(B0, 1, 0); PG8_LDB(B1, 1, 1); PG8_SCHED; PG8_LDA(At, 1, 0); PG8_STAGE(PG8_SA(0, 1), a2 + hstepA, voffA);
            PG8_WAIT_V(8); PG8_WAIT_L(0); PG8_BAR; PG8_MMA(0, 0, At, B0); PG8_MMA(0, 1, At, B1); PG8_BAR; PG8_SCHED;
            PG8_LDA(At, 1, 1); PG8_STAGE(PG8_SB(1, 0), b3, voffB); PG8_STAGE(PG8_SB(1, 1), b3 + hstepB, voffB); PG8_STAGE(PG8_SA(1, 0), a3, voffA);
            PG8_WAIT_V(8); PG8_WAIT_L(0); PG8_BAR; PG8_MMA(1, 0, At, B0); PG8_MMA(1, 1, At, B1); PG8_BAR; PG8_SCHED;
        }
        if (wr == 0) PG8_BAR;
        E(acc, cur, wr, wc, fr, fq);
        if (!has_next) break;
#pragma unroll
        for (int a = 0; a < 2; ++a)
#pragma unroll
            for (int b = 0; b < 2; ++b)
#pragma unroll
                for (int m = 0; m < 4; ++m)
#pragma unroll
                    for (int n = 0; n < 2; ++n) acc[a][b][m][n] = (f32x4){0.f, 0.f, 0.f, 0.f};
        cur = nxt; cA = nA; cB = nB; ++ui;
        if (wr == 1) PG8_BAR;
    }
    PG8_WAIT_V(0);
    PG8_BAR;
#undef PG8_SA
#undef PG8_SB
#undef PG8_STAGE
#undef PG8_LDA
#undef PG8_LDB
#undef PG8_MMA
#undef PG8_WAIT_V
#undef PG8_WAIT_L
#undef PG8_BAR
#undef PG8_SCHED
}
}
using pg8::Unit;

struct Params {
    const float* in[25];
    float* out;
    unsigned char* ws;
    int ph_lo, ph_hi;
};
enum { I_XP = 0, I_XS, I_CK, I_CV, I_ST, I_CMK, I_CMV, I_MEM, I_LN0W, I_LN0B, I_WIN, I_WSW, I_WHG, I_WMX, I_SINK, I_LBND, I_HNW, I_WMKV, I_WO, I_LN1W, I_LN1B,
       I_WF1, I_WF2, I_LN2W, I_LN2B };

struct SchedIn {
    int K, lda, G, c; const char* A; const char* B;
    DI int ldb() const { return K; }
    DI bool next(int i, Unit& u) const { const int L = i * G + c; if (L >= 3332) return false;
        if (L < 3300) pg8::swz_tile(L, 132, 25, u.pm, u.pn); else { const int l = L - 3300; u.pm = 132 + (l >> 2); u.pn = 25 + (l & 3); } u.k = 0; return true; }
    DI const char* pa(const Unit& u) const { return A + (size_t)u.pm * (256 * 1024 * 2); }
    DI const char* pb(const Unit& u) const { return B + (size_t)u.pn * (256 * 1024 * 2); }
};
struct SchedUp {
    int K, lda, G, c; const char* A; const char* B;
    DI int ldb() const { return K; }
    DI bool next(int i, Unit& u) const { const int L = (i / 3) * G + c; if (L >= 512) return false; pg8::swz_tile(L, 128, 4, u.pm, u.pn); u.k = i % 3; return true; }
    DI const char* pa(const Unit& u) const { const int co = u.k == 0 ? C_SQ : (u.k == 1 ? C_HQ : C_MQ); return A + (size_t)u.pm * (256 * (size_t)NPJ * 2) + co * 2; }
    DI const char* pb(const Unit& u) const { return B + (size_t)(u.k * 1024 + u.pn * 256) * (512 * 2); }
};
struct SchedUpS {
    int K, lda, pm, pn; const char* A; const char* B;
    DI int ldb() const { return K; }
    DI bool next(int i, Unit& u) const { if (i >= 3) return false; u.pm = pm; u.pn = pn; u.k = i; return true; }
    DI const char* pa(const Unit& u) const { const int co = u.k == 0 ? C_SQ : (u.k == 1 ? C_HQ : C_MQ); return A + (size_t)u.pm * (256 * (size_t)NPJ * 2) + co * 2; }
    DI const char* pb(const Unit& u) const { return B + (size_t)(u.k * 1024 + u.pn * 256) * (512 * 2); }
};
struct SchedOne {
    int K, lda, pm, pn; const char* A; const char* B;
    DI int ldb() const { return K; }
    DI bool next(int i, Unit& u) const { if (i >= 1) return false; u.pm = pm; u.pn = pn; u.k = 0; return true; }
    DI const char* pa(const Unit& u) const { return A + (size_t)u.pm * (256 * (size_t)lda * 2); }
    DI const char* pb(const Unit& u) const { return B + (size_t)u.pn * (256 * (size_t)K * 2); }
};
struct SchedHalfK {
    int K, lda, pm, pn, half; const char* A; const char* B;
    DI int ldb() const { return DFF; }
    DI bool next(int i, Unit& u) const { if (i >= 1) return false; u.pm = pm; u.pn = pn; u.k = half; return true; }
    DI const char* pa(const Unit& u) const { return A + (size_t)u.pm * (256 * (size_t)lda * 2) + (size_t)half * (1408 * 2); }
    DI const char* pb(const Unit& u) const { return B + (size_t)u.pn * (256 * (size_t)DFF * 2) + (size_t)half * (1408 * 2); }
};
struct SchedPlain {
    int K, lda, G, c; const char* A; const char* B; int nM, nN;
    DI int ldb() const { return K; }
    DI bool next(int i, Unit& u) const { const int L = i * G + c; if (L >= nM * nN) return false; pg8::swz_tile(L, nM, nN, u.pm, u.pn); u.k = 0; return true; }
    DI const char* pa(const Unit& u) const { return A + (size_t)u.pm * (256 * (size_t)lda * 2); }
    DI const char* pb(const Unit& u) const { return B + (size_t)u.pn * (256 * (size_t)K * 2); }
};

typedef f32x4 Acc[2][2][4][2];
struct EpiIn {
    bf16_t* proj; float* out; const float* lb; bf16_t* mkb; bf16_t* mvt; bf16_t* vtsw; bf16_t* ksw; int mode;
    DI void operator()(Acc& acc, const Unit& u, int wr, int wc, int fr, int fq) const {
        asm volatile("" : "+v"(fr), "+v"(fq));
        const int pn = u.pn;
        f32x4 lbv[2][2];
        if (u.pm < 132 && (pn == 5 || pn == 6)) {
#pragma unroll
            for (int bj = 0; bj < 2; ++bj) { const int c = (pn - 5) * 256 + bj * 128 + wc * 32 + fq * 8; lbv[bj][0] = *(const f32x4*)(lb + c); lbv[bj][1] = *(const f32x4*)(lb + c + 4); }
        }
        if (u.pm >= 132) {
            const int b = u.pm - 132, kv = (pn - 25) >> 1;
#pragma unroll
            for (int ai = 0; ai < 2; ++ai)
#pragma unroll
                for (int m = 0; m < 4; ++m) { const int s = ai * 128 + wr * 64 + m * 16 + fr;
#pragma unroll
                    for (int bj = 0; bj < 2; ++bj) { const int h = 2 * ((pn - 25) & 1) + bj, d = wc * 32 + fq * 8;
                        const f32x4 v0 = acc[ai][bj][m][0], v1 = acc[ai][bj][m][1];
                        float* o = out + (kv ? O_MVP : O_MKP) + ((size_t)(b * 256 + s) * 4 + h) * 128 + d;
                        *(f32x4*)o = v0; *(f32x4*)(o + 4) = v1;
                        if (kv == 0) *(u32x4*)(mkb + ((((((size_t)(b * 4 + h) * 8 + (s >> 5)) * 8 + (d >> 4)) * 2 + ((d >> 3) & 1)) * 32 + (s & 31)) * 8)) = pack8(v0, v1);
                        else { const int w16 = s & 15; bf16_t* t = mvt + (((((size_t)(b * 4 + h) * 16 + (s >> 4)) * 2 + ((w16 >> 2) & 1)) * 128 + d) * 8) + (w16 & 3) + 4 * (w16 >> 3);
#pragma unroll
                            for (int j = 0; j < 4; ++j) { t[j * 8] = f2bf(v0[j]); t[(4 + j) * 8] = f2bf(v1[j]); } } } }
            return;
        }
#pragma unroll
        for (int ai = 0; ai < 2; ++ai)
#pragma unroll
            for (int m = 0; m < 4; ++m) { const int row = u.pm * 256 + ai * 128 + wr * 64 + m * 16 + fr;
                bf16_t* prow = proj + (size_t)row * NPJ + pn * 256 + wc * 32 + fq * 8;
#pragma unroll
                for (int bj = 0; bj < 2; ++bj) { f32x4 v0 = acc[ai][bj][m][0], v1 = acc[ai][bj][m][1];
                    if (pn == 2) {
                        const int kvh = wc >> 1, d = (wc & 1) * 32 + fq * 8;
                        float* o = nullptr;
                        if (row >= MP) { const int bs = (row - MP) >> 3, t = (row - MP) & 7; o = out + (bj ? O_VWS : O_KWS) + ((size_t)(bs * 128 + 120 + t) * 2 + kvh) * 64 + d; }
                        else { const int t = row & 4095; if (t >= 3968) o = out + (bj ? O_VWP : O_KWP) + ((size_t)((row >> 12) * 128 + t - 3968) * 2 + kvh) * 64 + d; }
                        if (o) { *(f32x4*)o = v0; *(f32x4*)(o + 4) = v1; }
                        if (row < MP) { const int tt = row & 4095, bk = ((row >> 12) * 2 + kvh);
                            if (bj == 0) *(u32x4*)(ksw + ((((((size_t)bk * 128 + (tt >> 5)) * 4 + (d >> 4)) * 2 + ((d >> 3) & 1)) * 32 + (tt & 31)) * 8)) = pack8(v0, v1);
                            else { const int w16 = tt & 15; bf16_t* t = vtsw + (((((size_t)bk * 256 + (tt >> 4)) * 2 + ((w16 >> 2) & 1)) * 64 + d) * 8) + (w16 & 3) + 4 * (w16 >> 3);
#pragma unroll
                                for (int j = 0; j < 4; ++j) { t[j * 8] = f2bf(v0[j]); t[(4 + j) * 8] = f2bf(v1[j]); } } }
                        continue;
                    }
                    if (pn < 2) { v0 *= 0.125f * LOG2E; v1 *= 0.125f * LOG2E; }
                    else if (pn < 5 || (pn >= 9 && pn < 11)) {
#pragma unroll
                        for (int j = 0; j < 4; ++j) { v0[j] = fsilu(v0[j]); v1[j] = fsilu(v1[j]); } }
                    else if (pn < 7) { const f32x4 l0 = lbv[bj][0], l1 = lbv[bj][1];
#pragma unroll
                        for (int j = 0; j < 4; ++j) { v0[j] = flog(l0[j] + (1.0f - l0[j]) * fsigmoid(v0[j])); v1[j] = flog(l1[j] + (1.0f - l1[j]) * fsigmoid(v1[j])); } }
                    else if (pn < 9) {}
                    else if (pn < 13) { v0 *= 0.08838834764831845f * LOG2E; v1 *= 0.08838834764831845f * LOG2E; }
                    else {
#pragma unroll
                        for (int j = 0; j < 4; ++j) { v0[j] = fsigmoid(v0[j]); v1[j] = fsigmoid(v1[j]); } }
                    const u32x4 w8 = pack8(v0, v1);
                    if (mode == 0) *(u32x4*)(prow + bj * 128) = w8; else asm volatile("" :: "v"(w8));
                } }
    }
};
struct EpiUp {
    bf16_t* proj; bool dry;
    DI void operator()(Acc& acc, const Unit& u, int wr, int wc, int fr, int fq) const {
        asm volatile("" : "+v"(fr), "+v"(fq));
        bf16_t* base = proj + (size_t)(u.pm * 256 + wr * 64 + fr) * NPJ + C_GL + u.pn * 256 + wc * 32 + fq * 8;
        {
            u32x4 g[2][4][2];
#pragma unroll
            for (int ai = 0; ai < 2; ++ai)
#pragma unroll
                for (int m = 0; m < 4; ++m)
#pragma unroll
                    for (int bj = 0; bj < 2; ++bj) g[ai][m][bj] = *(const u32x4*)(base + (size_t)(ai * 128 + m * 16) * NPJ + u.k * 1024 + bj * 128);
#pragma unroll
            for (int ai = 0; ai < 2; ++ai)
#pragma unroll
                for (int m = 0; m < 4; ++m)
#pragma unroll
                    for (int bj = 0; bj < 2; ++bj) { const u32x4 q = g[ai][m][bj]; f32x4& v0 = acc[ai][bj][m][0]; f32x4& v1 = acc[ai][bj][m][1];
                        v0[0] *= bflo(q.x); v0[1] *= bfhi(q.x); v0[2] *= bflo(q.y); v0[3] *= bfhi(q.y); v1[0] *= bflo(q.z); v1[1] *= bfhi(q.z); v1[2] *= bflo(q.w); v1[3] *= bfhi(q.w); }
        }
        if (u.k > 0) {
            u32x4 g[2][4][2];
#pragma unroll
            for (int ai = 0; ai < 2; ++ai)
#pragma unroll
                for (int m = 0; m < 4; ++m)
#pragma unroll
                    for (int bj = 0; bj < 2; ++bj) g[ai][m][bj] = *(const u32x4*)(base + (size_t)(ai * 128 + m * 16) * NPJ + bj * 128);
#pragma unroll
            for (int ai = 0; ai < 2; ++ai)
#pragma unroll
                for (int m = 0; m < 4; ++m)
#pragma unroll
                    for (int bj = 0; bj < 2; ++bj) { const u32x4 q = g[ai][m][bj]; f32x4& v0 = acc[ai][bj][m][0]; f32x4& v1 = acc[ai][bj][m][1];
                        v0[0] += bflo(q.x); v0[1] += bfhi(q.x); v0[2] += bflo(q.y); v0[3] += bfhi(q.y); v1[0] += bflo(q.z); v1[1] += bfhi(q.z); v1[2] += bflo(q.w); v1[3] += bfhi(q.w); }
        }
        if (!dry) {
#pragma unroll
            for (int ai = 0; ai < 2; ++ai)
#pragma unroll
                for (int m = 0; m < 4; ++m)
#pragma unroll
                    for (int bj = 0; bj < 2; ++bj) *(u32x4*)(base + (size_t)(ai * 128 + m * 16) * NPJ + bj * 128) = pack8(acc[ai][bj][m][0], acc[ai][bj][m][1]);
        }
    }
};
struct EpiRes {
    bf16_t* proj; const bf16_t* res; int rp;
    DI void operator()(Acc& acc, const Unit& u, int wr, int wc, int fr, int fq) const {
        asm volatile("" : "+v"(fr), "+v"(fq));
        const int row0 = u.pm * 256 + wr * 64 + fr, col0 = u.pn * 256 + wc * 32 + fq * 8;
        u32x4 g[2][4][2];
#pragma unroll
        for (int ai = 0; ai < 2; ++ai)
#pragma unroll
            for (int m = 0; m < 4; ++m)
#pragma unroll
                for (int bj = 0; bj < 2; ++bj) g[ai][m][bj] = *(const u32x4*)(res + (size_t)(row0 + ai * 128 + m * 16) * rp + col0 + bj * 128);
#pragma unroll
        for (int ai = 0; ai < 2; ++ai)
#pragma unroll
            for (int m = 0; m < 4; ++m)
#pragma unroll
                for (int bj = 0; bj < 2; ++bj) { const u32x4 p = g[ai][m][bj]; f32x4 v0 = acc[ai][bj][m][0], v1 = acc[ai][bj][m][1];
                    v0[0] += ALPHA * bflo(p.x); v0[1] += ALPHA * bfhi(p.x); v0[2] += ALPHA * bflo(p.y); v0[3] += ALPHA * bfhi(p.y);
                    v1[0] += ALPHA * bflo(p.z); v1[1] += ALPHA * bfhi(p.z); v1[2] += ALPHA * bflo(p.w); v1[3] += ALPHA * bfhi(p.w);
                    *(u32x4*)(proj + (size_t)(row0 + ai * 128 + m * 16) * NPJ + C_Z + col0 + bj * 128) = pack8(v0, v1); }
    }
};
struct EpiNull {
    DI void operator()(Acc& acc, const Unit& u, int wr, int wc, int fr, int fq) const {
#pragma unroll
        for (int ai = 0; ai < 2; ++ai)
#pragma unroll
            for (int bj = 0; bj < 2; ++bj)
#pragma unroll
                for (int m = 0; m < 4; ++m)
#pragma unroll
                    for (int n = 0; n < 2; ++n) asm volatile("" :: "v"(acc[ai][bj][m][n]));
    }
};
struct EpiPart {
    float* zp;
    DI void operator()(Acc& acc, const Unit& u, int wr, int wc, int fr, int fq) const {
        asm volatile("" : "+v"(fr), "+v"(fq));
#pragma unroll
        for (int ai = 0; ai < 2; ++ai)
#pragma unroll
            for (int m = 0; m < 4; ++m) { float* p = zp + ((size_t)u.k * 1024 + (size_t)(u.pm - 128) * 256 + ai * 128 + wr * 64 + m * 16 + fr) * 1024 + u.pn * 256 + wc * 32 + fq * 8;
#pragma unroll
                for (int bj = 0; bj < 2; ++bj) { *(f32x4*)(p + bj * 128) = acc[ai][bj][m][0]; *(f32x4*)(p + bj * 128 + 4) = acc[ai][bj][m][1]; } }
    }
};
struct EpiGlu {
    bf16_t* proj; int mode;
    DI void operator()(Acc& acc, const Unit& u, int wr, int wc, int fr, int fq) const {
        asm volatile("" : "+v"(fr), "+v"(fq));
#pragma unroll
        for (int ai = 0; ai < 2; ++ai)
#pragma unroll
            for (int m = 0; m < 4; ++m) { const int row = u.pm * 256 + ai * 128 + wr * 64 + m * 16 + fr;
                f32x4 v0, v1;
#pragma unroll
                for (int j = 0; j < 4; ++j) { v0[j] = fsilu(acc[ai][0][m][0][j]) * acc[ai][1][m][0][j]; v1[j] = fsilu(acc[ai][0][m][1][j]) * acc[ai][1][m][1][j]; }
                const u32x4 w8 = pack8(v0, v1);
                if (mode == 0) *(u32x4*)(proj + (size_t)row * NPJ + C_ACT + u.pn * 128 + wc * 32 + fq * 8) = w8; else asm volatile("" :: "v"(w8)); }
    }
};

DI int crow(int reg, int h) { return (reg & 3) + 8 * (reg >> 2) + 4 * h; }
DI bf16x8 pack_step(const f32x16& x, int s) { u32x4 p; p.x = pk2(x[8 * s], x[8 * s + 1]); p.y = pk2(x[8 * s + 2], x[8 * s + 3]); p.z = pk2(x[8 * s + 4], x[8 * s + 5]); p.w = pk2(x[8 * s + 6], x[8 * s + 7]); return __builtin_bit_cast(bf16x8, p); }
#define MFMA32(a, b, c) __builtin_amdgcn_mfma_f32_32x32x16_bf16((a), (b), (c), 0, 0, 0)
#define MFMA16(a, b, c) __builtin_amdgcn_mfma_f32_16x16x32_bf16((a), (b), (c), 0, 0, 0)

template <class T> DI void attn_item(const T& t) {
    constexpr int D = T::D, NCH = T::NCH;
    const int lane = threadIdx.x & 63, r = lane & 31, h = lane >> 5;
    bf16x8 qf[D / 16], kf[D / 16];
#pragma unroll
    for (int kk = 0; kk < D / 16; ++kk) qf[kk] = t.qfrag(r, 16 * kk + 8 * h);
    const int cbeg = t.cbeg();
    if (!T::VSPLIT) {
#pragma unroll
        for (int kk = 0; kk < D / 16; ++kk) kf[kk] = t.kfrag_t(t.tile(cbeg), kk);
    }
    float m = t.m_init(r), l = t.l_init();
    f32x16 o[D / 32];
#pragma unroll
    for (int dd = 0; dd < D / 32; ++dd)
#pragma unroll
        for (int i = 0; i < 16; ++i) o[dd][i] = 0.f;
    bf16x8 vf[2][D / 32];
#pragma unroll 1
    for (int c = cbeg; c < NCH; ++c) {
        const int tl = t.tile(c);
        if (!T::VSPLIT) {
#pragma unroll
            for (int s2 = 0; s2 < 2; ++s2)
#pragma unroll
                for (int dd = 0; dd < D / 32; ++dd) vf[s2][dd] = t.vfrag_t(tl, s2, dd);
        }
        f32x16 s;
        t.init_s(s, tl);
        if (T::VSPLIT) {
#pragma unroll
            for (int kk = 0; kk < D / 16; ++kk) kf[kk] = t.kfrag_t(tl, kk);
        }
#pragma unroll
        for (int kk = 0; kk < D / 16; ++kk) s = MFMA32(kf[kk], qf[kk], s);
        if (!T::VSPLIT && c + 1 < NCH) {
#pragma unroll
            for (int kk = 0; kk < D / 16; ++kk) kf[kk] = t.kfrag_t(tl + 1, kk); }
        t.post_s(s, tl, r, h);
        float mx = s[0];
#pragma unroll
        for (int i = 1; i < 16; ++i) mx = fmaxf(mx, s[i]);
        mx = fmaxf(mx, __shfl_xor(mx, 32));
        const bool need = mx > m + 8.0f;
        if (__builtin_amdgcn_ballot_w64(need) != 0ull) {
            const float mn = need ? mx : m;
            const float sc = fexp2(m - mn);
            l *= sc; m = mn;
#pragma unroll
            for (int dd = 0; dd < D / 32; ++dd)
#pragma unroll
                for (int i = 0; i < 16; ++i) o[dd][i] *= sc;
        }
        float ps = 0.f;
#pragma unroll
        for (int i = 0; i < 16; ++i) { const float p = fexp2(s[i] - m); s[i] = p; ps += p; }
        ps += __shfl_xor(ps, 32);
        l += ps;
#pragma unroll
        for (int s2 = 0; s2 < 2; ++s2) { const bf16x8 pb = pack_step(s, s2);
            if (T::VSPLIT) {
#pragma unroll
                for (int dd = 0; dd < D / 32; ++dd) vf[s2][dd] = t.vfrag_t(tl, s2, dd);
            }
#pragma unroll
            for (int dd = 0; dd < D / 32; ++dd) o[dd] = MFMA32(vf[s2][dd], pb, o[dd]); }
    }
    const float inv = frcp(l);
#pragma unroll
    for (int dd = 0; dd < D / 32; ++dd)
#pragma unroll
        for (int g = 0; g < 4; ++g) { u32x2 w; w.x = pk2(o[dd][4 * g] * inv, o[dd][4 * g + 1] * inv); w.y = pk2(o[dd][4 * g + 2] * inv, o[dd][4 * g + 3] * inv); t.ostore(r, 32 * dd + 8 * g + 4 * h, w); }
}
DI void zero16(f32x16& s) {
#pragma unroll
    for (int i = 0; i < 16; ++i) s[i] = 0.f;
}
struct AttSwP {
    static constexpr int D = 64, NCH = 5; static constexpr bool VSPLIT = false;
    bf16_t* qo; const bf16_t* kb; const bf16_t* vb; int g; float slope2, sink2, lc; bool dry;
    DI AttSwP(bf16_t* proj, const bf16_t* vt, const bf16_t* ks, int b, int hd, int g_, float sl2, float sk2, bool dry_) {
        const int lane = threadIdx.x & 63, r = lane & 31, h = lane >> 5, bk = b * 2 + (hd >> 2);
        qo = proj + (size_t)(b * 4096 + 32 * g_ + r) * NPJ + C_SQ + hd * 64; kb = ks + (size_t)bk * (128 * 2048) + h * 256 + r * 8; vb = vt + (size_t)bk * (256 * 1024) + h * 512 + r * 8;
        g = g_; slope2 = sl2; sink2 = sk2; lc = sl2 * (float)(32 * g_ + r); dry = dry_; }
    DI bf16x8 qfrag(int, int d0) const { return *(const bf16x8*)(qo + d0); }
    DI float m_init(int) const { return sink2; }
    DI float l_init() const { return 1.0f; }
    DI int cbeg() const { return g < 4 ? 4 - g : 0; }
    DI int tile(int c) const { return g - 4 + c; }
    DI bf16x8 kfrag_t(int tl, int kk) const { return *(const bf16x8*)(kb + (size_t)tl * 2048 + kk * 512); }
    DI bf16x8 vfrag_t(int tl, int s2, int dd) const { return *(const bf16x8*)(vb + (size_t)tl * 2048 + s2 * 1024 + dd * 256); }
    DI void init_s(f32x16& s, int tl) const { const int h = (threadIdx.x & 63) >> 5; const float c0 = slope2 * (float)(32 * tl) - lc;
#pragma unroll
        for (int i = 0; i < 16; ++i) s[i] = slope2 * (float)crow(i, h) + c0; }
    DI void post_s(f32x16& s, int tl, int r, int h) const {
        if (tl == g - 4) {
#pragma unroll
            for (int i = 0; i < 16; ++i) s[i] = crow(i, h) > r ? s[i] : -INFINITY; }
        if (tl == g) {
#pragma unroll
            for (int i = 0; i < 16; ++i) s[i] = crow(i, h) <= r ? s[i] : -INFINITY; } }
    DI void ostore(int, int d, u32x2 w) const { if (!dry) *(u32x2*)(qo + d) = w; }
};
struct AttSwS {
    static constexpr int D = 64, NCH = 5; static constexpr bool VSPLIT = true;
    bf16_t* proj; const float* ck; const float* cv; const float* nk; const float* nv; const float* sinks; int b, kvh; bool dry;
    DI bf16x8 qfrag(int r, int d0) const { return *(const bf16x8*)(proj + (size_t)(MP + b * 8 + (r & 7)) * NPJ + C_SQ + (kvh * 4 + (r >> 3)) * 64 + d0); }
    DI float m_init(int r) const { return sinks[kvh * 4 + (r >> 3)] * LOG2E; }
    DI float l_init() const { return 1.0f; }
    DI int cbeg() const { return 0; }
    DI int tile(int c) const { return c; }
    DI const float* krow(const float* c, const float* n, int kk) const { kk = kk > 135 ? 135 : kk; return kk < 128 ? c + ((size_t)(b * 128 + kk) * 2 + kvh) * 64 : n + ((size_t)(b * 128 + kk - 8) * 2 + kvh) * 64; }
    DI bf16x8 kfrag_t(int tl, int kk) const { const int lane = threadIdx.x & 63; return ld8f_bf(krow(ck, nk, 32 * tl + (lane & 31)) + 16 * kk + 8 * (lane >> 5)); }
    DI bf16x8 vfrag_t(int tl, int s2, int dd) const { const int lane = threadIdx.x & 63, d = 32 * dd + (lane & 31), ka = 32 * tl + 16 * s2 + 4 * (lane >> 5); f32x4 a, c;
#pragma unroll
        for (int j = 0; j < 4; ++j) { a[j] = krow(cv, nv, ka + j)[d]; c[j] = krow(cv, nv, ka + 8 + j)[d]; }
        return __builtin_bit_cast(bf16x8, pack8(a, c)); }
    DI void init_s(f32x16& s, int) const { zero16(s); }
    DI void post_s(f32x16& s, int tl, int r, int h) const { const float sl = fexp2(-(float)(kvh * 4 + (r >> 3) + 1)) * LOG2E;
#pragma unroll
        for (int i = 0; i < 16; ++i) { const int dist = 128 + (r & 7) - (32 * tl + crow(i, h)); s[i] = (dist >= 0 && dist < 128) ? s[i] - sl * (float)dist : -INFINITY; } }
    DI void ostore(int r, int d, u32x2 w) const { if (!dry) *(u32x2*)(proj + (size_t)(MP + b * 8 + (r & 7)) * NPJ + C_SQ + (kvh * 4 + (r >> 3)) * 64 + d) = w; }
};
struct AttMemP {
    static constexpr int D = 128, NCH = 8; static constexpr bool VSPLIT = false;
    bf16_t* qo; const bf16_t* kb; const bf16_t* vb; bool dry;
    DI AttMemP(bf16_t* proj, const bf16_t* mk, const bf16_t* mvt, int b, int hd, int g, bool dry_) {
        const int lane = threadIdx.x & 63, r = lane & 31, h = lane >> 5, bh = b * 4 + hd;
        qo = proj + (size_t)(b * 4096 + 32 * g + r) * NPJ + C_MQ + hd * 128; kb = mk + (size_t)bh * (8 * 4096) + h * 256 + r * 8; vb = mvt + (size_t)bh * (16 * 2048) + h * 1024 + r * 8; dry = dry_; }
    DI bf16x8 qfrag(int, int d0) const { return *(const bf16x8*)(qo + d0); }
    DI float m_init(int) const { return -INFINITY; }
    DI float l_init() const { return 0.0f; }
    DI int cbeg() const { return 0; }
    DI int tile(int c) const { return c; }
    DI bf16x8 kfrag_t(int tl, int kk) const { return *(const bf16x8*)(kb + (size_t)tl * 4096 + kk * 512); }
    DI bf16x8 vfrag_t(int tl, int s2, int dd) const { return *(const bf16x8*)(vb + (size_t)tl * 4096 + s2 * 2048 + dd * 256); }
    DI void init_s(f32x16& s, int) const { zero16(s); }
    DI void post_s(f32x16&, int, int, int) const {}
    DI void ostore(int, int d, u32x2 w) const { if (!dry) *(u32x2*)(qo + d) = w; }
};
struct AttMemS {
    static constexpr int D = 128, NCH = 8; static constexpr bool VSPLIT = true;
    bf16_t* proj; const float* mk; const float* mv; int b, hd; bool dry;
    DI bf16x8 qfrag(int r, int d0) const { return *(const bf16x8*)(proj + (size_t)(MP + b * 8 + (r & 7)) * NPJ + C_MQ + hd * 128 + d0); }
    DI float m_init(int) const { return -INFINITY; }
    DI float l_init() const { return 0.0f; }
    DI int cbeg() const { return 0; }
    DI int tile(int c) const { return c; }
    DI bf16x8 kfrag_t(int tl, int kk) const { const int lane = threadIdx.x & 63; return ld8f_bf(mk + ((size_t)(b * 256 + 32 * tl + (lane & 31)) * 4 + hd) * 128 + 16 * kk + 8 * (lane >> 5)); }
    DI bf16x8 vfrag_t(int tl, int s2, int dd) const { const int lane = threadIdx.x & 63; const float* p = mv + ((size_t)(b * 256 + 32 * tl + 16 * s2 + 4 * (lane >> 5)) * 4 + hd) * 128 + 32 * dd + (lane & 31); f32x4 a, c;
#pragma unroll
        for (int j = 0; j < 4; ++j) { a[j] = p[(size_t)j * 512]; c[j] = p[(size_t)(8 + j) * 512]; }
        return __builtin_bit_cast(bf16x8, pack8(a, c)); }
    DI void init_s(f32x16& s, int) const { zero16(s); }
    DI void post_s(f32x16&, int, int, int) const {}
    DI void ostore(int r, int d, u32x2 w) const { if (r < 8 && !dry) *(u32x2*)(proj + (size_t)(MP + b * 8 + r) * NPJ + C_MQ + hd * 128 + d) = w; }
};

constexpr int HQ_OFF = 0, HK_OFF = 17408, HKT_OFF = 34816, HVT_OFF = 53248, HA_OFF = 71680, HD_OFF = 80896, HBP_OFF = 81408, HSS_OFF = 83456, HRS_OFF = 85504;
constexpr int HOB_OFF = 85760, OBP = 132;
constexpr int QP = 136, TP = 72;
template <bool OUT> DI void hgrn_item(LAS unsigned char* lds, bf16_t* proj, float* hst, float* hdv, const float* normw, int item, bool dry) {
    const int tid = threadIdx.x, lane = tid & 63, w = __builtin_amdgcn_readfirstlane(tid >> 6);
    const int b = item >> 6, h = (item >> 4) & 3, c = item & 15;
    const int d = tid & 127, tq = tid >> 7;
    LAS bf16_t* Qt = (LAS bf16_t*)(lds + HQ_OFF); LAS bf16_t* Kt = (LAS bf16_t*)(lds + HK_OFF); LAS bf16_t* KtT = (LAS bf16_t*)(lds + HKT_OFF);
    LAS bf16_t* VT = (LAS bf16_t*)(lds + HVT_OFF); LAS bf16_t* Ab = (LAS bf16_t*)(lds + HA_OFF);
    LAS float* Dv = (LAS float*)(lds + HD_OFF); LAS float* bpart = (LAS float*)(lds + HBP_OFF); LAS float* ssq = (LAS float*)(lds + HSS_OFF); LAS float* rsd = (LAS float*)(lds + HRS_OFF);
    const int e16 = lane & 15, rq = lane >> 4;
    f32x4 st[8];
    float* hs = hst + (size_t)item * 16384 + (size_t)(w * 8) * 256 + lane * 4;
    if (OUT) {
#pragma unroll
        for (int i = 0; i < 8; ++i) st[i] = *(const f32x4*)(hs + i * 256);
    } else {
#pragma unroll
        for (int i = 0; i < 8; ++i) st[i] = (f32x4){0.f, 0.f, 0.f, 0.f};
    }
    float btot = 0.f;
    unsigned rg[8], rqv[8], rvv[8];
#define HG_LOAD(SC) do { const size_t r0_ = (size_t)b * 4096 + c * 256 + (SC) * 64 + tq * 16; const bf16_t* pg_ = proj + r0_ * NPJ + h * 128 + d; \
        _Pragma("unroll") for (int i = 0; i < 8; ++i) { const bf16_t* p0_ = pg_ + (size_t)(2 * i) * NPJ; const bf16_t* p1_ = p0_ + NPJ; \
            rg[i] = (unsigned)p0_[C_HF] | ((unsigned)p1_[C_HF] << 16); rvv[i] = (unsigned)p0_[C_HI] | ((unsigned)p1_[C_HI] << 16); \
            if (OUT) rqv[i] = (unsigned)p0_[C_HQ] | ((unsigned)p1_[C_HQ] << 16); } } while (0)
    HG_LOAD(0);
#pragma unroll 1
    for (int sc = 0; sc < 4; ++sc) {
        const size_t row0 = (size_t)b * 4096 + c * 256 + sc * 64;
        float gl[16], qv[16];
#pragma unroll
        for (int i = 0; i < 8; ++i) { gl[2 * i] = bflo(rg[i]); gl[2 * i + 1] = bfhi(rg[i]); if (OUT) { qv[2 * i] = bflo(rqv[i]); qv[2 * i + 1] = bfhi(rqv[i]); } }
        *(LAS u32x4*)(VT + d * TP + tq * 16) = (u32x4){rvv[0], rvv[1], rvv[2], rvv[3]};
        *(LAS u32x4*)(VT + d * TP + tq * 16 + 8) = (u32x4){rvv[4], rvv[5], rvv[6], rvv[7]};
        if (sc < 3) HG_LOAD(sc + 1);
        float run = 0.f;
        float bl[16];
#pragma unroll
        for (int i = 0; i < 16; ++i) { run += gl[i]; bl[i] = run; }
        bpart[tq * 128 + d] = run;
        __syncthreads();
        float off = 0.f, tot = 0.f;
#pragma unroll
        for (int q = 0; q < 4; ++q) { const float p = bpart[q * 128 + d]; tot += p; if (q < tq) off += p; }
        btot += tot;
        if (tq == 0) Dv[d] = fexp(tot);
        {
            unsigned kk[8];
#pragma unroll
            for (int i = 0; i < 8; ++i) {
                const float b0 = off + bl[2 * i], b1 = off + bl[2 * i + 1];
                const float k0 = (1.0f - fexp(gl[2 * i])) * fexp(-b0), k1 = (1.0f - fexp(gl[2 * i + 1])) * fexp(-b1);
                kk[i] = pk2(k0, k1);
                if (OUT) { Kt[(tq * 16 + 2 * i) * QP + d] = (bf16_t)(kk[i] & 0xffffu); Kt[(tq * 16 + 2 * i + 1) * QP + d] = (bf16_t)(kk[i] >> 16);
                    Qt[(tq * 16 + 2 * i) * QP + d] = f2bf(qv[2 * i] * fexp(b0)); Qt[(tq * 16 + 2 * i + 1) * QP + d] = f2bf(qv[2 * i + 1] * fexp(b1)); }
            }
            *(LAS u32x4*)(KtT + d * TP + tq * 16) = (u32x4){kk[0], kk[1], kk[2], kk[3]};
            *(LAS u32x4*)(KtT + d * TP + tq * 16 + 8) = (u32x4){kk[4], kk[5], kk[6], kk[7]};
        }
        __syncthreads();
        f32x4 o[4];
        bf16x8 vfr[2];
#pragma unroll
        for (int ks = 0; ks < 2; ++ks) vfr[ks] = *(const LAS bf16x8*)(VT + (w * 16 + e16) * TP + 32 * ks + 8 * rq);
        if (OUT) {
#pragma unroll
            for (int u = 0; u < 2; ++u) { const int id = w + 8 * u, ti = id >> 2, sj = id & 3;
                f32x4 a = {0.f, 0.f, 0.f, 0.f};
                if (sj <= ti) {
#pragma unroll
                    for (int ks = 0; ks < 4; ++ks) { const bf16x8 qa = *(const LAS bf16x8*)(Qt + (16 * ti + e16) * QP + 32 * ks + 8 * rq), kb = *(const LAS bf16x8*)(Kt + (16 * sj + e16) * QP + 32 * ks + 8 * rq);
                        a = MFMA16(qa, kb, a); }
                }
#pragma unroll
                for (int r = 0; r < 4; ++r) { const int tt = 16 * ti + 4 * rq + r, ss = 16 * sj + e16; Ab[tt * TP + ss] = (sj <= ti && ss <= tt) ? f2bf(a[r]) : (bf16_t)0; }
            }
#pragma unroll
            for (int ti = 0; ti < 4; ++ti) { o[ti] = (f32x4){0.f, 0.f, 0.f, 0.f};
#pragma unroll
                for (int ks = 0; ks < 4; ++ks) { const LAS bf16_t* qp = Qt + (16 * ti + e16) * QP + 32 * ks + 4 * rq; const u32x2 q0 = *(const LAS u32x2*)qp, q1 = *(const LAS u32x2*)(qp + 16);
                    u32x4 qa = {q0.x, q0.y, q1.x, q1.y};
                    u32x4 sb; sb.x = pk2(st[2 * ks][0], st[2 * ks][1]); sb.y = pk2(st[2 * ks][2], st[2 * ks][3]); sb.z = pk2(st[2 * ks + 1][0], st[2 * ks + 1][1]); sb.w = pk2(st[2 * ks + 1][2], st[2 * ks + 1][3]);
                    o[ti] = MFMA16(__builtin_bit_cast(bf16x8, qa), __builtin_bit_cast(bf16x8, sb), o[ti]); } }
        }
#pragma unroll
        for (int dt = 0; dt < 8; ++dt) {
#pragma unroll
            for (int ks = 0; ks < 2; ++ks) { const bf16x8 ka = *(const LAS bf16x8*)(KtT + (16 * dt + e16) * TP + 32 * ks + 8 * rq); st[dt] = MFMA16(ka, vfr[ks], st[dt]); }
            const f32x4 dv = *(const LAS f32x4*)(Dv + 16 * dt + 4 * rq);
            st[dt] *= dv;
        }
        u32x4 gate8[2];
        if (OUT) {
#pragma unroll
            for (int j = 0; j < 2; ++j) { const int cch = tid + 512 * j; gate8[j] = *(const u32x4*)(proj + (row0 + (cch >> 4)) * NPJ + C_HG + h * 128 + 8 * (cch & 15)); }
        }
        __syncthreads();
        if (OUT) {
#pragma unroll
            for (int ti = 0; ti < 4; ++ti)
#pragma unroll
                for (int ks = 0; ks < 2; ++ks) if (2 * ks <= ti) { const bf16x8 aa = *(const LAS bf16x8*)(Ab + (16 * ti + e16) * TP + 32 * ks + 8 * rq); o[ti] = MFMA16(aa, vfr[ks], o[ti]); }
            LAS float* Ob = (LAS float*)(lds + HOB_OFF);
#pragma unroll
            for (int ti = 0; ti < 4; ++ti)
#pragma unroll
                for (int r = 0; r < 4; ++r) Ob[(16 * ti + 4 * rq + r) * OBP + w * 16 + e16] = o[ti][r];
            __syncthreads();
#pragma unroll
            for (int j = 0; j < 2; ++j) { const int cch = tid + 512 * j, tt = cch >> 4, e0 = 8 * (cch & 15);
                const f32x4 a0 = *(const LAS f32x4*)(Ob + tt * OBP + e0), a1 = *(const LAS f32x4*)(Ob + tt * OBP + e0 + 4);
                float q = (a0[0] * a0[0] + a0[1] * a0[1]) + (a0[2] * a0[2] + a0[3] * a0[3]) + (a1[0] * a1[0] + a1[1] * a1[1]) + (a1[2] * a1[2] + a1[3] * a1[3]);
                q += __shfl_xor(q, 1); q += __shfl_xor(q, 2); q += __shfl_xor(q, 4); q += __shfl_xor(q, 8);
                const float rs = __builtin_amdgcn_rsqf(q * (1.0f / 128.0f) + 1e-6f);
                const f32x4 n0 = *(const f32x4*)(normw + e0), n1 = *(const f32x4*)(normw + e0 + 4); const u32x4 g = gate8[j];
                f32x4 y0, y1;
                y0[0] = a0[0] * rs * n0[0] * bflo(g.x); y0[1] = a0[1] * rs * n0[1] * bfhi(g.x); y0[2] = a0[2] * rs * n0[2] * bflo(g.y); y0[3] = a0[3] * rs * n0[3] * bfhi(g.y);
                y1[0] = a1[0] * rs * n1[0] * bflo(g.z); y1[1] = a1[1] * rs * n1[1] * bfhi(g.z); y1[2] = a1[2] * rs * n1[2] * bflo(g.w); y1[3] = a1[3] * rs * n1[3] * bfhi(g.w);
                if (!dry) *(u32x4*)(proj + (row0 + tt) * NPJ + C_HQ + h * 128 + e0) = pack8(y0, y1); }
        }
    }
    if (!OUT) {
#pragma unroll
        for (int i = 0; i < 8; ++i) *(f32x4*)(hs + i * 256) = st[i];
        if (tq == 0) hdv[(size_t)item * 128 + d] = fexp(btot);
    }
}
DI void hgrn_scan(float* hst, const float* hdv, float* out, int gt, bool dry) {
    const int bh = gt >> 12, rem = gt & 4095, w = rem >> 9, tile = (rem >> 6) & 7, lane = rem & 63;
    const int d0 = 16 * tile + 4 * (lane >> 4), e = 16 * w + (lane & 15);
    f32x4 S = {0.f, 0.f, 0.f, 0.f};
#pragma unroll 4
    for (int c = 0; c < 16; ++c) { const int item = bh * 16 + c; float* p = hst + (size_t)item * 16384 + (size_t)(w * 8 + tile) * 256 + lane * 4;
        const f32x4 loc = *(const f32x4*)p; const f32x4 dv = *(const f32x4*)(hdv + (size_t)item * 128 + d0);
        if (!dry) *(f32x4*)p = S; S = dv * S + loc; }
#pragma unroll
    for (int r = 0; r < 4; ++r) out[O_SP + ((size_t)bh * 128 + d0 + r) * 128 + e] = S[r];
}
DI void hgrn_sample_item(LAS unsigned char* lds, bf16_t* proj, const float* state, float* out, const float* normw, int item, bool dry) {
    const int tid = threadIdx.x, lane = tid & 63, w = tid >> 6;
    const int b = item >> 2, h = item & 3, e = tid & 127, dq = tid >> 7;
    LAS float* F = (LAS float*)lds;
    LAS float* Kk = F + 1024;
    LAS float* Q = Kk + 1024;
    LAS float* V = Q + 1024;
    LAS float* OP = V + 1024;
    for (int i = tid; i < 1024; i += 512) { const int t = i >> 7, dd = i & 127; const bf16_t* pr = proj + (size_t)(MP + b * 8 + t) * NPJ + h * 128 + dd;
        const float f = fexp(bf2f(pr[C_HF])); F[i] = f; Kk[i] = 1.0f - f; Q[i] = bf2f(pr[C_HQ]); V[i] = bf2f(pr[C_HI]); }
    float S[32];
    const float* sp = state + ((size_t)(b * 4 + h) * 128 + dq * 32) * 128 + e;
#pragma unroll
    for (int i = 0; i < 32; ++i) S[i] = sp[(size_t)i * 128];
    __syncthreads();
#pragma unroll 1
    for (int t = 0; t < 8; ++t) { const float v = V[t * 128 + e]; float op = 0.f;
#pragma unroll
        for (int i = 0; i < 32; ++i) { const int dd = dq * 32 + i; S[i] = F[t * 128 + dd] * S[i] + Kk[t * 128 + dd] * v; op += Q[t * 128 + dd] * S[i]; }
        OP[(t * 4 + dq) * 128 + e] = op; }
    float* so = out + O_SS + ((size_t)(b * 4 + h) * 128 + dq * 32) * 128 + e;
#pragma unroll
    for (int i = 0; i < 32; ++i) so[(size_t)i * 128] = S[i];
    __syncthreads();
    {
        const int t = w; float o0 = 0.f, o1 = 0.f;
#pragma unroll
        for (int q = 0; q < 4; ++q) { o0 += OP[(t * 4 + q) * 128 + lane]; o1 += OP[(t * 4 + q) * 128 + 64 + lane]; }
        float ss = o0 * o0 + o1 * o1;
#pragma unroll
        for (int x = 1; x < 64; x <<= 1) ss += __shfl_xor(ss, x);
        const float rs = __builtin_amdgcn_rsqf(ss * (1.0f / 128.0f) + 1e-6f);
        bf16_t* pr = proj + (size_t)(MP + b * 8 + t) * NPJ + h * 128;
        const float g0 = bf2f(pr[C_HG + lane]), g1 = bf2f(pr[C_HG + 64 + lane]);
        __syncthreads();
        if (!dry) { pr[C_HQ + lane] = f2bf(o0 * rs * normw[lane] * g0); pr[C_HQ + 64 + lane] = f2bf(o1 * rs * normw[64 + lane] * g1); }
    }
    __syncthreads();
}

DI float wave_sum(float v) {
#pragma unroll
    for (int o = 1; o < 64; o <<= 1) v += __shfl_xor(v, o);
    return v;
}
DI void transpose_item(const float* W, int K, int N, bf16_t* WT, int k0, int n0, int drow0, LAS float* scr, int lane) {
#pragma unroll 8
    for (int i = 0; i < 32; ++i) { const int kk = 2 * i + (lane >> 5); scr[kk * 33 + (lane & 31)] = W[(size_t)(k0 + kk) * N + n0 + (lane & 31)]; }
    asm volatile("s_waitcnt lgkmcnt(0)" ::: "memory");
    const int c = lane & 7;
#pragma unroll
    for (int j = 0; j < 4; ++j) { const int n = (lane >> 3) + 8 * j; const LAS float* s = scr + (8 * c) * 33 + n;
        u32x4 o; o.x = pk2(s[0 * 33], s[1 * 33]); o.y = pk2(s[2 * 33], s[3 * 33]); o.z = pk2(s[4 * 33], s[5 * 33]); o.w = pk2(s[6 * 33], s[7 * 33]);
        *(u32x4*)(WT + (size_t)(drow0 + n) * K + k0 + 8 * c) = o; }
    asm volatile("s_waitcnt lgkmcnt(0)" ::: "memory");
}
DI void ln_row_f32_to_bf16(const float* x, const float* w, const float* bb, bf16_t* o, int lane) {
    const f32x4* xr = (const f32x4*)x + lane; f32x4 v[4]; float s = 0.f;
#pragma unroll
    for (int j = 0; j < 4; ++j) { v[j] = xr[64 * j]; s += (v[j][0] + v[j][1]) + (v[j][2] + v[j][3]); }
    const float mean = wave_sum(s) * (1.f / 1024.f); float s2 = 0.f;
#pragma unroll
    for (int j = 0; j < 4; ++j) { v[j] = v[j] - mean; s2 += (v[j][0] * v[j][0] + v[j][1] * v[j][1]) + (v[j][2] * v[j][2] + v[j][3] * v[j][3]); }
    const float rstd = __builtin_amdgcn_rsqf(wave_sum(s2) * (1.f / 1024.f) + 1e-5f);
#pragma unroll
    for (int j = 0; j < 4; ++j) { const f32x4 ww = ((const f32x4*)w)[64 * j + lane], bv = ((const f32x4*)bb)[64 * j + lane]; const f32x4 y = v[j] * rstd * ww + bv;
        u32x2 p; p.x = pk2(y[0], y[1]); p.y = pk2(y[2], y[3]); ((u32x2*)o)[64 * j + lane] = p; }
}
template <bool F32OUT> DI void ln_row_bf16(const bf16_t* z, const float* w, const float* bb, void* o, int lane) {
    float v[16]; float s = 0.f;
#pragma unroll
    for (int j = 0; j < 2; ++j) { const u32x4 p = *(const u32x4*)(z + 512 * j + 8 * lane);
        v[8 * j + 0] = bflo(p.x); v[8 * j + 1] = bfhi(p.x); v[8 * j + 2] = bflo(p.y); v[8 * j + 3] = bfhi(p.y); v[8 * j + 4] = bflo(p.z); v[8 * j + 5] = bfhi(p.z); v[8 * j + 6] = bflo(p.w); v[8 * j + 7] = bfhi(p.w); }
#pragma unroll
    for (int i = 0; i < 16; ++i) s += v[i];
    const float mean = wave_sum(s) * (1.f / 1024.f); float s2 = 0.f;
#pragma unroll
    for (int i = 0; i < 16; ++i) { v[i] -= mean; s2 += v[i] * v[i]; }
    const float rstd = __builtin_amdgcn_rsqf(wave_sum(s2) * (1.f / 1024.f) + 1e-5f);
#pragma unroll
    for (int j = 0; j < 2; ++j) { const int c = 512 * j + 8 * lane; const f32x4 w0 = *(const f32x4*)(w + c), w1 = *(const f32x4*)(w + c + 4), b0 = *(const f32x4*)(bb + c), b1 = *(const f32x4*)(bb + c + 4);
        f32x4 y0, y1;
#pragma unroll
        for (int i = 0; i < 4; ++i) { y0[i] = v[8 * j + i] * rstd * w0[i] + b0[i]; y1[i] = v[8 * j + 4 + i] * rstd * w1[i] + b1[i]; }
        if (F32OUT) { *(f32x4*)((float*)o + c) = y0; *(f32x4*)((float*)o + c + 4) = y1; }
        else *(u32x4*)((bf16_t*)o + c) = pack8(y0, y1); }
}

#define XB_TMO      128
#define XB_XCNT(j)  (256  + 64 * (j))
#define XB_XSUB(j)  (1280 + 64 * (j))
#define XB_XGEN(j)  (2304 + 64 * (j))
#define XB_TOP      3328
#define XB_TOPGEN   3392
#define XCD_BAR_WORDS 3456
#define XB_SPIN_CAP (1u << 18)

__device__ __forceinline__ unsigned xb_ld(unsigned* p)              { return __hip_atomic_load(p, __ATOMIC_RELAXED, __HIP_MEMORY_SCOPE_AGENT); }
__device__ __forceinline__ unsigned xb_add(unsigned* p, unsigned v) { return __hip_atomic_fetch_add(p, v, __ATOMIC_RELAXED, __HIP_MEMORY_SCOPE_AGENT); }
__device__ __forceinline__ unsigned xb_xcc_id() { return (unsigned)__builtin_amdgcn_s_getreg((3 << 11) | 20) & 0xFu; }
#define XB_SPIN(cond, bar) do { unsigned _sp = 0; while (cond) { __builtin_amdgcn_s_sleep(1); \
    if ((++_sp & 255u) == 0u) { if (xb_ld(&(bar)[XB_TMO])) break; if (_sp > XB_SPIN_CAP) { atomicAdd(&(bar)[XB_TMO], 1u); break; } } } } while (0)

struct XcdBarrier {
    unsigned* bar; unsigned x;
    volatile LAS unsigned* st;
};

__device__ __forceinline__ XcdBarrier xcd_barrier_post(unsigned* bar, volatile LAS unsigned* st) {
    XcdBarrier b; b.bar = bar; b.x = xb_xcc_id(); b.st = st;
    if (threadIdx.x == 0) (void)xb_add(&bar[XB_XCNT(b.x)], 1u);
    return b;
}
__device__ __forceinline__ void xcd_barrier_complete(unsigned* bar, unsigned x, unsigned& nloc, unsigned& nx) {
    const unsigned G = gridDim.x * gridDim.y * gridDim.z;
    unsigned sum, cnt, mine, sp = 0u;
    for (;;) {
        sum = 0u; cnt = 0u; mine = 0u;
#pragma unroll
        for (unsigned j = 0; j < 16; ++j) { const unsigned c = xb_ld(&bar[XB_XCNT(j)]); sum += c; cnt += (c > 0u) ? 1u : 0u; mine = (j == x) ? c : mine; }
        if (sum == G) break;
        __builtin_amdgcn_s_sleep(1);
        if ((++sp & 255u) == 0u) { if (xb_ld(&bar[XB_TMO])) break; if (sp > XB_SPIN_CAP) { atomicAdd(&bar[XB_TMO], 1u); break; } }
    }
    nloc = mine > 0u ? mine : 1u; nx = cnt > 0u ? cnt : 1u;
}

__device__ __forceinline__ void xcd_barrier(const XcdBarrier& b) {
    asm volatile("s_waitcnt vmcnt(0)" ::: "memory");
    __syncthreads();
    if (threadIdx.x == 0) {
        unsigned* bar = b.bar;
        __builtin_amdgcn_s_waitcnt(0);
        unsigned nloc = b.st[0], nx = b.st[1];
        if (nloc == 0u) { xcd_barrier_complete(bar, b.x, nloc, nx); b.st[0] = nloc; b.st[1] = nx; }
        const unsigned old = xb_add(&bar[XB_XSUB(b.x)], 1u);
        const unsigned gen = old / nloc;
        if (old + 1u == (gen + 1u) * nloc) {
            __builtin_amdgcn_fence(__ATOMIC_RELEASE, "agent");
            asm volatile("s_waitcnt vmcnt(0)" ::: "memory");
            const unsigned og = xb_add(&bar[XB_TOP], 1u);
            const unsigned tg = og / nx;
            if (og + 1u == (tg + 1u) * nx) xb_add(&bar[XB_TOPGEN], 1u);
            else XB_SPIN(xb_ld(&bar[XB_TOPGEN]) == tg, bar);
            __builtin_amdgcn_fence(__ATOMIC_ACQUIRE, "agent");
            xb_add(&bar[XB_XGEN(b.x)], 1u);
            asm volatile("s_waitcnt vmcnt(0)" ::: "memory");
        } else {
            XB_SPIN(xb_ld(&bar[XB_XGEN(b.x)]) == gen, bar);
            __builtin_amdgcn_fence(__ATOMIC_ACQUIRE, "agent");
            asm volatile("s_waitcnt vmcnt(0)" ::: "memory");
        }
    }
    __syncthreads();
}


DI void ln_row_sample(const bf16_t* hrow, const float* z0, const float* z1, const float* w, const float* bb, float* o, int lane) {
    float v[16]; float s = 0.f;
#pragma unroll
    for (int j = 0; j < 2; ++j) { const int c = 512 * j + 8 * lane; const u32x4 p = *(const u32x4*)(hrow + c);
        const f32x4 a0 = *(const f32x4*)(z0 + c), a1 = *(const f32x4*)(z0 + c + 4), b0 = *(const f32x4*)(z1 + c), b1 = *(const f32x4*)(z1 + c + 4);
        v[8 * j + 0] = ALPHA * bflo(p.x) + a0[0] + b0[0]; v[8 * j + 1] = ALPHA * bfhi(p.x) + a0[1] + b0[1]; v[8 * j + 2] = ALPHA * bflo(p.y) + a0[2] + b0[2]; v[8 * j + 3] = ALPHA * bfhi(p.y) + a0[3] + b0[3];
        v[8 * j + 4] = ALPHA * bflo(p.z) + a1[0] + b1[0]; v[8 * j + 5] = ALPHA * bfhi(p.z) + a1[1] + b1[1]; v[8 * j + 6] = ALPHA * bflo(p.w) + a1[2] + b1[2]; v[8 * j + 7] = ALPHA * bfhi(p.w) + a1[3] + b1[3]; }
#pragma unroll
    for (int i = 0; i < 16; ++i) s += v[i];
    const float mean = wave_sum(s) * (1.f / 1024.f); float s2 = 0.f;
#pragma unroll
    for (int i = 0; i < 16; ++i) { v[i] -= mean; s2 += v[i] * v[i]; }
    const float rstd = __builtin_amdgcn_rsqf(wave_sum(s2) * (1.f / 1024.f) + 1e-5f);
#pragma unroll
    for (int j = 0; j < 2; ++j) { const int c = 512 * j + 8 * lane; const f32x4 w0 = *(const f32x4*)(w + c), w1 = *(const f32x4*)(w + c + 4), b0 = *(const f32x4*)(bb + c), b1 = *(const f32x4*)(bb + c + 4);
        f32x4 y0, y1;
#pragma unroll
        for (int i = 0; i < 4; ++i) { y0[i] = v[8 * j + i] * rstd * w0[i] + b0[i]; y1[i] = v[8 * j + 4 + i] * rstd * w1[i] + b1[i]; }
        *(f32x4*)(o + c) = y0; *(f32x4*)(o + c + 4) = y1; }
}
constexpr int LDS_BYTES = 131072 + 1024;
__global__ void __launch_bounds__(512, 2) fwd_kernel(Params P) {
    extern __shared__ __attribute__((aligned(16))) unsigned char lds_raw[];
    LAS unsigned char* lds = (LAS unsigned char*)lds_raw;
    cg::grid_group grid = cg::this_grid();
    volatile LAS unsigned* bst = (volatile LAS unsigned*)(lds + 131072 + 512);
    if (threadIdx.x < 2) bst[threadIdx.x] = 0u;
    __syncthreads();
    XcdBarrier xbar = xcd_barrier_post((unsigned*)(P.ws + W_BAR), bst);
    const int tid = threadIdx.x, lane = tid & 63, wave = __builtin_amdgcn_readfirstlane(tid >> 6);
    const int G = gridDim.x, cu = blockIdx.x;
    const int gw = cu * 8 + wave, NGW = G * 8;
    unsigned char* sc = (unsigned char*)P.out;
    bf16_t* WT_IN = (bf16_t*)(sc + S_WTIN); bf16_t* WT_UP = (bf16_t*)(sc + S_WTUP); bf16_t* WT_O = (bf16_t*)(sc + S_WTO); bf16_t* WT_F1 = (bf16_t*)(sc + S_WTF1); bf16_t* WT_F2 = (bf16_t*)(sc + S_WTF2);
    bf16_t* XN = (bf16_t*)(sc + S_XN); bf16_t* MKB = (bf16_t*)(sc + S_MKB); bf16_t* MVT = (bf16_t*)(sc + S_MVT); bf16_t* VTSW = (bf16_t*)(sc + S_VTSW); bf16_t* KSW = (bf16_t*)(sc + S_KSW); float* LB = (float*)(sc + S_LB);
    bf16_t* PROJ = (bf16_t*)(P.ws + W_PROJ); float* HST = (float*)(P.ws + W_HST); float* HDV = (float*)(P.ws + W_HD);
    const int lo = P.ph_lo, hi = P.ph_hi;
#ifndef ATT_MASK
#define ATT_MASK 15
#endif
#ifndef PHASE_MASK
#define PHASE_MASK 0x1fff
#endif
#define IN(k) (((PHASE_MASK >> (k)) & 1) && lo <= (k) && (k) < hi)
#ifndef DUP_MASK
#define DUP_MASK 0
#endif
#ifndef PROBE_P8
#define PROBE_P8 0
#endif
#ifndef PROBE_P1
#define PROBE_P1 0
#endif
#ifndef ATT_DRY_MASK
#define ATT_DRY_MASK 31
#endif
#define REPS(k) for (int rep_ = 0, nrep_ = 1 + ((DUP_MASK >> (k)) & 1); rep_ < nrep_; ++rep_)
#define DRY (rep_ + 1 < nrep_)
#define SEAM(k) do { if (IN(k) && IN((k) + 1)) { if (P.ph_lo < 0) grid.sync(); else xcd_barrier(xbar); } } while (0)

    if (IN(0)) REPS(0) {
        LAS float* scr = (LAS float*)(lds + wave * 8704);
        constexpr int IT_IN = 16 * 200, IT_MKV = 16 * 32, IT_UP = 8 * 32, IT_O = 16 * 32, IT_F1 = 16 * 176, IT_F2 = 44 * 32;
        constexpr int NIT = IT_IN + IT_MKV;
        for (int it = gw; it < NIT; it += NGW) {
            int r = it;
            if (r < IT_IN) { const int kb = r / 200, nb = r % 200; transpose_item(P.in[I_WIN], 1024, 6400, WT_IN, 64 * kb, 32 * nb, 32 * nb, scr, lane); continue; } r -= IT_IN;
            { const int kb = r / 32, nb = r % 32; transpose_item(P.in[I_WMKV], 1024, 1024, WT_IN, 64 * kb, 32 * nb, 6400 + 32 * nb, scr, lane); }
        }
        for (int m = gw; m < MT; m += NGW) { const float* x = m < MP ? P.in[I_XP] + (size_t)m * 1024 : P.in[I_XS] + (size_t)(m - MP) * 1024; ln_row_f32_to_bf16(x, P.in[I_LN0W], P.in[I_LN0B], XN + (size_t)m * 1024, lane); }
        for (int m = gw; m < 2048; m += NGW) { const f32x4* xr = (const f32x4*)(P.in[I_MEM] + (size_t)m * 1024) + lane; u32x2* o = (u32x2*)(XN + (size_t)(MT + m) * 1024) + lane;
#pragma unroll
            for (int j = 0; j < 4; ++j) { const f32x4 v = xr[64 * j]; u32x2 p; p.x = pk2(v[0], v[1]); p.y = pk2(v[2], v[3]); o[64 * j] = p; } }
        for (int i = cu * 512 + tid; i < 128 * 120 * 32; i += G * 512) { const int q = i & 31, j = (i >> 5) % 120, b = (i >> 5) / 120;
            const size_t src = ((size_t)(b * 128 + j + 8) * 128) + q * 4, dst = ((size_t)(b * 128 + j) * 128) + q * 4;
            *(f32x4*)(P.out + O_KWS + dst) = *(const f32x4*)(P.in[I_CK] + src); *(f32x4*)(P.out + O_VWS + dst) = *(const f32x4*)(P.in[I_CV] + src); }
        if (cu == 0) { const float a0 = P.in[I_LBND][tid], a1 = P.in[I_LBND][512 + tid]; LB[tid] = frcp(1.0f + fexp(a1 - a0)); }
    }
    SEAM(0);
    if (IN(1)) REPS(1) {
        SchedIn S{1024, 1024, G, cu, (const char*)XN, (const char*)WT_IN};
#if PROBE_P1 == 1
        if (DRY) { EpiNull E0; pg8::gemm_phase(lds, S, E0); } else
#elif PROBE_P1 == 2
        if (DRY) { EpiIn E0{PROJ, P.out, LB, MKB, MVT, VTSW, KSW, 1}; pg8::gemm_phase(lds, S, E0); } else
#endif
        { EpiIn E{PROJ, P.out, LB, MKB, MVT, VTSW, KSW, 0}; pg8::gemm_phase(lds, S, E); }
        if (cu >= 4) {
            LAS float* scr = (LAS float*)(lds + wave * 8704);
            constexpr int IT_UP = 8 * 32, IT_O = 16 * 32, IT_F1 = 16 * 176, IT_F2 = 44 * 32, NIT1 = 3 * IT_UP + IT_O + IT_F1 + IT_F2;
            for (int it = (cu - 4) * 8 + wave; it < NIT1; it += (G - 4) * 8) {
                int r = it;
                if (r < 3 * IT_UP) { const int k = r / IT_UP, q = r % IT_UP, kb = q / 32, nb = q % 32; transpose_item(P.in[I_WSW + k], 512, 1024, WT_UP + (size_t)k * 1024 * 512, 64 * kb, 32 * nb, 32 * nb, scr, lane); continue; } r -= 3 * IT_UP;
                if (r < IT_O) { const int kb = r / 32, nb = r % 32; transpose_item(P.in[I_WO], 1024, 1024, WT_O, 64 * kb, 32 * nb, 32 * nb, scr, lane); continue; } r -= IT_O;
                if (r < IT_F1) { const int kb = r / 176, nb = r % 176; const int n0 = 32 * nb; const int drow = n0 < DFF ? (n0 / 128) * 256 + (n0 % 128) : ((n0 - DFF) / 128) * 256 + 128 + ((n0 - DFF) % 128);
                    transpose_item(P.in[I_WF1], 1024, 5632, WT_F1, 64 * kb, n0, drow, scr, lane); continue; } r -= IT_F1;
                { const int kb = r / 32, nb = r % 32; transpose_item(P.in[I_WF2], 2816, 1024, WT_F2, 64 * kb, 32 * nb, 32 * nb, scr, lane); }
            }
        }
    }
    SEAM(1);
    LAS unsigned* qctr = (LAS unsigned*)(lds + 131072 + 528);
#define ATT_Q_RESET() do { __syncthreads(); if (tid == 0) *qctr = 0u; __syncthreads(); } while (0)
#define ATT_Q_NEXT() __builtin_amdgcn_readfirstlane(lane == 0 ? (int)__hip_atomic_fetch_add(qctr, 1u, __ATOMIC_RELAXED, __HIP_MEMORY_SCOPE_WORKGROUP) : 0)
    if (IN(2)) REPS(2) {
        for (int it = cu; it < 512; it += G) { hgrn_item<false>(lds, PROJ, HST, HDV, P.in[I_HNW], it, DRY); __syncthreads(); }
        for (int it = cu; it < 512; it += G) hgrn_sample_item(lds, PROJ, P.in[I_ST], P.out, P.in[I_HNW], it, DRY);
        ATT_Q_RESET();
        for (int it = ATT_Q_NEXT() * G + cu; it < 768; it = ATT_Q_NEXT() * G + cu) {
            if (it < 512) { AttMemS t{PROJ, P.in[I_CMK], P.in[I_CMV], it >> 2, it & 3, DRY}; attn_item(t); }
            else { const int r = it - 512; AttSwS t{PROJ, P.in[I_CK], P.in[I_CV], P.out + O_KWS, P.out + O_VWS, P.in[I_SINK], r >> 1, r & 1, DRY}; attn_item(t); }
        }
    }
    SEAM(2);
#define ATT_RUN(LO, HI, WS) do { const int ws_ = (WS), W_ = 240 * 16 + 16 * ws_, ns_ = cu < 16 ? ws_ : 16; ATT_Q_RESET(); \
        for (;;) { const int j_ = ATT_Q_NEXT(), q_ = j_ % ns_, it_ = (LO) + (j_ / ns_) * W_ + (cu < 16 ? 3840 + cu + 16 * q_ : (cu - 16) + 240 * q_); if (it_ >= (HI)) break; \
            if (it_ < 4096) { AttMemP t(PROJ, MKB, MVT, it_ >> 9, (it_ >> 7) & 3, it_ & 127, DRY); attn_item(t); } \
            else { const int r_ = it_ - 4096, hd_ = (r_ >> 7) & 7; AttSwP t(PROJ, VTSW, KSW, r_ >> 10, hd_, r_ & 127, fexp2(-(float)(hd_ + 1)) * LOG2E, P.in[I_SINK][hd_] * LOG2E, DRY); attn_item(t); } } } while (0)
    constexpr int ATT_SPLIT = 9000, ATT_TOTAL = 12288;
    if (IN(3)) REPS(3) {
        if (cu >= 16) for (int gt = (cu - 16) * 512 + tid; gt < 131072; gt += (G - 16) * 512) hgrn_scan(HST, HDV, P.out, gt, DRY);
        if (cu < 16) { SchedUpS S{512, NPJ, 128 + (cu >> 2), cu & 3, (const char*)PROJ, (const char*)WT_UP}; EpiUp E{PROJ, DRY}; pg8::gemm_phase(lds, S, E); }
        ATT_RUN(0, ATT_SPLIT, 1);
    }
    SEAM(3);
    if (IN(4)) REPS(4) {
        if (cu < 16) { SchedOne S{1024, NPJ, 128 + (cu >> 2), cu & 3, (const char*)(PROJ + C_MIX), (const char*)WT_O}; EpiRes E{PROJ, XN, 1024}; pg8::gemm_phase(lds, S, E); }
        ATT_RUN(ATT_SPLIT, ATT_TOTAL, 2);
    }
    SEAM(4);
    if (IN(5)) REPS(5) {
        for (int it = cu; it < 512; it += G) { hgrn_item<true>(lds, PROJ, HST, HDV, P.in[I_HNW], it, DRY); __syncthreads(); }
    }
    SEAM(5);
    if (IN(6)) REPS(6) { SchedUp S{512, NPJ, G, cu, (const char*)PROJ, (const char*)WT_UP}; EpiUp E{PROJ, DRY}; pg8::gemm_phase(lds, S, E); }
    SEAM(6);
    if (IN(7)) REPS(7) { SchedPlain S{1024, NPJ, G, cu, (const char*)(PROJ + C_MIX), (const char*)WT_O, 128, 4}; EpiRes E{PROJ, XN, 1024}; pg8::gemm_phase(lds, S, E); }
    SEAM(7);
    if (IN(8)) REPS(8) { for (int m = gw; m < MT; m += NGW) ln_row_bf16<false>(PROJ + (size_t)m * NPJ + C_Z, P.in[I_LN1W], P.in[I_LN1B], PROJ + (size_t)m * NPJ + C_H, lane); }
    SEAM(8);
    if (IN(9)) REPS(9) { SchedPlain S{1024, NPJ, G, cu, (const char*)(PROJ + C_H), (const char*)WT_F1, 132, 22};
#if PROBE_P8 == 1
        if (DRY) { EpiNull E0; pg8::gemm_phase(lds, S, E0); } else
#elif PROBE_P8 == 2
        if (DRY) { EpiGlu E0{PROJ, 1}; pg8::gemm_phase(lds, S, E0); } else
#endif
        { EpiGlu E{PROJ, 0}; pg8::gemm_phase(lds, S, E); } }
    SEAM(9);
    if (IN(10)) REPS(10) { SchedPlain S{2816, NPJ, G, cu, (const char*)(PROJ + C_ACT), (const char*)WT_F2, 128, 4}; EpiRes E{PROJ, PROJ + C_H, NPJ}; pg8::gemm_phase(lds, S, E); }
    SEAM(10);
    float* ZP = (float*)(P.ws + W_ZP);
    if (IN(11)) REPS(11) {
        if (cu < 32) { SchedHalfK S{1408, NPJ, 128 + (cu >> 3), (cu >> 1) & 3, cu & 1, (const char*)(PROJ + C_ACT), (const char*)WT_F2}; EpiPart E{ZP}; pg8::gemm_phase(lds, S, E); }
        else { for (int m = (cu - 32) * 8 + wave; m < MP; m += (G - 32) * 8) if (m < 7808 || m >= 9216) ln_row_bf16<true>(PROJ + (size_t)m * NPJ + C_Z, P.in[I_LN2W], P.in[I_LN2B], P.out + O_YP + (size_t)m * 1024, lane); }
    }
    SEAM(11);
    if (IN(12)) REPS(12) {
        for (int i = gw; i < 1408 + MS; i += NGW) {
            if (i < 1408) { const int m = 7808 + i; ln_row_bf16<true>(PROJ + (size_t)m * NPJ + C_Z, P.in[I_LN2W], P.in[I_LN2B], P.out + O_YP + (size_t)m * 1024, lane); }
            else { const int m = i - 1408; ln_row_sample(PROJ + (size_t)(MP + m) * NPJ + C_H, ZP + (size_t)m * 1024, ZP + (size_t)(1024 + m) * 1024, P.in[I_LN2W], P.in[I_LN2B], P.out + O_YS + (size_t)m * 1024, lane); }
        }
    }
}

#ifndef N_LAUNCH_MODE
#define N_LAUNCH_MODE 1
#endif
extern "C" void kernel_launch(void* const* d_in, const int* in_sizes, int n_in, void* d_out, int out_size, void* d_ws, size_t ws_size, hipStream_t stream) {
    static bool attr_done = false;
    if (!attr_done) { hipFuncSetAttribute((const void*)fwd_kernel, hipFuncAttributeMaxDynamicSharedMemorySize, LDS_BYTES); attr_done = true; }
    if (ws_size < W_END) { fprintf(stderr, "kernel_launch: workspace too small: %zu < %zu\n", ws_size, (size_t)W_END); }
    Params p{};
    for (int i = 0; i < 25; ++i) p.in[i] = (const float*)d_in[i];
    p.out = (float*)d_out; p.ws = (unsigned char*)d_ws;
    const int grid = 256;
#if N_LAUNCH_MODE == 1
    p.ph_lo = 0; p.ph_hi = 13;
    hipMemsetAsync((char*)d_ws + W_BAR, 0, 16384, stream);
    void* args[] = {&p};
    hipError_t e = hipLaunchCooperativeKernel((const void*)fwd_kernel, dim3(grid), dim3(512), args, LDS_BYTES, stream);
    if (e != hipSuccess) fprintf(stderr, "cooperative launch failed: %s\n", hipGetErrorString(e));
#else
    for (int ph = 0; ph < 13; ++ph) { p.ph_lo = ph; p.ph_hi = ph + 1; hipLaunchKernelGGL(fwd_kernel, dim3(grid), dim3(512), LDS_BYTES, stream, p); }
#endif
}
```

```cpp
#include <hip/hip_runtime.h>
#include <hip/hip_cooperative_groups.h>
#include <cstdio>
#include <cstdint>
namespace cg = cooperative_groups;

#define LAS __attribute__((address_space(3)))
typedef unsigned short bf16_t;
typedef short bf16x8 __attribute__((ext_vector_type(8)));
typedef short s16x4 __attribute__((ext_vector_type(4)));
typedef float f32x4 __attribute__((ext_vector_type(4)));
typedef float f32x2 __attribute__((ext_vector_type(2)));
typedef float f32x16 __attribute__((ext_vector_type(16)));
typedef unsigned u32x4 __attribute__((ext_vector_type(4)));
typedef unsigned u32x2 __attribute__((ext_vector_type(2)));
typedef __bf16 bfv2 __attribute__((ext_vector_type(2)));
#define DI __device__ __forceinline__

constexpr int DM = 1024, BATCH = 8, SEQ = 4096, DECB = 128, DECS = 8;
constexpr int MP = BATCH * SEQ, MS = DECB * DECS, MT = MP + MS;
constexpr int NPJ = 6400;
constexpr int C_SQ = 0, C_SK = 512, C_HQ = 768, C_HF = 1280, C_HI = 1792, C_HG = 2304, C_MQ = 2816, C_GL = 3328;
constexpr int C_MIX = 3328, C_Z = 0, C_H = 1024, C_ACT = 2048;
constexpr int DFF = 2816;
constexpr float ALPHA = 1.189207115f;
constexpr float LOG2E = 1.4426950408889634f;
constexpr size_t O_YP = 0, O_YS = 33554432, O_KWP = 34603008, O_VWP = 34734080, O_SP = 34865152, O_MKP = 35389440, O_MVP = 36438016,
                 O_KWS = 37486592, O_VWS = 39583744, O_SS = 41680896;
constexpr size_t S_WTIN = 0, S_WTMKV = 13107200, S_WTUP = 15204352, S_WTO = 18350080, S_WTF1 = 20447232, S_WTF2 = 31981568,
                 S_XN = 37748736, S_MKB = 111149056, S_MVT = 113246208, S_VTSW = 115343360, S_LB = 123731968, S_KSW = 123736064;
constexpr size_t W_PROJ = 0, W_HST = 432537600, W_HD = 466092032, W_BAR = 466354176, W_ZP = 466370560, W_END = 466370560 + 8388608;

DI unsigned pk2(float lo, float hi) { f32x2 v = {lo, hi}; bfv2 b = __builtin_convertvector(v, bfv2); return __builtin_bit_cast(unsigned, b); }
DI bf16_t f2bf(float x) { return (bf16_t)(pk2(x, 0.f) & 0xffffu); }
DI float bf2f(bf16_t b) { return __uint_as_float(((unsigned)b) << 16); }
DI float bflo(unsigned w) { return __uint_as_float(w << 16); }
DI float bfhi(unsigned w) { return __uint_as_float(w & 0xffff0000u); }
DI float fexp2(float x) { return __builtin_amdgcn_exp2f(x); }
DI float fexp(float x) { return __builtin_amdgcn_exp2f(x * LOG2E); }
DI float frcp(float x) { return __builtin_amdgcn_rcpf(x); }
DI float fsigmoid(float x) { return frcp(1.0f + fexp(-x)); }
DI float fsilu(float x) { return x * fsigmoid(x); }
DI float flog(float x) { return __builtin_amdgcn_logf(x) * 0.6931471805599453f; }
DI u32x4 pack8(f32x4 a, f32x4 b) { u32x4 w; w.x = pk2(a[0], a[1]); w.y = pk2(a[2], a[3]); w.z = pk2(b[0], b[1]); w.w = pk2(b[2], b[3]); return w; }
DI bf16x8 ld8f_bf(const float* p) { const f32x4 a = *(const f32x4*)p, b = *(const f32x4*)(p + 4); return __builtin_bit_cast(bf16x8, pack8(a, b)); }

namespace pg8 {
constexpr int BM = 256, BK = 64, HALF = 128, HTB = HALF * BK * 2, STAGE_BYTES = 8 * HTB, NXCD = 8, WGM = 8;
__host__ __device__ __forceinline__ int lds_byte(int r, int c) { const int st = (r >> 4) * 2 + (c >> 5), rr = r & 15, cc = c & 31, ob = rr * 64 + cc * 2; return st * 1024 + (ob ^ (((ob >> 9) & 1) << 5)); }
__host__ __device__ __forceinline__ void stage_rc(int b, int& R, int& C) { const int st = b / 1024, sb = b % 1024, swz = sb ^ (((sb >> 9) & 1) << 5); R = (st >> 1) * 16 + swz / 64; C = (st & 1) * 32 + (swz % 64) / 2; }
__host__ __device__ __forceinline__ int perm32(int rho) { const int n = rho >> 4, i = rho & 15; return 8 * (i >> 2) + 4 * n + (i & 3); }
struct Unit { int pm, pn, k; };
DI void swz_tile(int L, int nM, int nN, int& pm, int& pn) {
    const int nwg = nM * nN; int wgid = L; { const int q = nwg / NXCD, r = nwg % NXCD, xcd = wgid % NXCD, off = wgid / NXCD; wgid = (xcd < r ? xcd * (q + 1) : r * (q + 1) + (xcd - r) * q) + off; }
    const int nig = WGM * nN, gid = wgid / nig, fm = gid * WGM, gsz = (nM - fm) < WGM ? (nM - fm) : WGM;
    pm = fm + ((wgid % nig) % gsz); pn = (wgid % nig) / gsz;
}
template <class Epi, class Sched>
DI void gemm_phase(LAS unsigned char* lds, const Sched& S, const Epi& E) {
    const int tid = threadIdx.x, wid = __builtin_amdgcn_readfirstlane(tid >> 6), lane = tid & 63, wr = wid >> 2, wc = wid & 3, fr = lane & 15, fq = lane >> 4;
    const int K = S.K, lda = S.lda, ldb = S.ldb(), nt = K / BK;
    unsigned voffA[2], voffB[2];
#pragma unroll
    for (int i = 0; i < 2; ++i) { int R, C; stage_rc(tid * 16 + i * 8192, R, C); const int Rb = (R & ~31) + perm32(R & 31);
        voffA[i] = (unsigned)(R * lda + C) * 2u; voffB[i] = (unsigned)(Rb * ldb + C) * 2u; }
    const size_t kstep = (size_t)(BK * 2);
    const size_t hstepA = (size_t)HALF * lda * 2, hstepB = (size_t)HALF * ldb * 2;
    const unsigned ldsw = (unsigned)wid * 1024u;
    const int aoff = lds_byte(wr * 64 + fr, fq * 8), boff = lds_byte(wc * 32 + fr, fq * 8);
#define PG8_SA(b, h) (((b) * 2 + (h)) * HTB)
#define PG8_SB(b, h) ((4 + (b) * 2 + (h)) * HTB)
#define PG8_STAGE(bufoff, gbase, voff) do { _Pragma("unroll") for (int _i = 0; _i < 2; ++_i) \
        __builtin_amdgcn_global_load_lds((const unsigned*)((const char*)(gbase) + (voff)[_i]), (LAS unsigned*)(lds + (bufoff) + ldsw + _i * 8192), 16, 0, 0); } while (0)
#define PG8_LDA(dst, b, h) do { _Pragma("unroll") for (int m = 0; m < 4; ++m) _Pragma("unroll") for (int k = 0; k < 2; ++k) dst[m][k] = *(const LAS bf16x8*)(lds + PG8_SA(b, h) + aoff + m * 2048 + k * 1024); } while (0)
#define PG8_LDB(dst, b, h) do { _Pragma("unroll") for (int n = 0; n < 2; ++n) _Pragma("unroll") for (int k = 0; k < 2; ++k) dst[n][k] = *(const LAS bf16x8*)(lds + PG8_SB(b, h) + boff + n * 2048 + k * 1024); } while (0)
#define PG8_MMA(ai, bj, At, Bt) do { __builtin_amdgcn_s_setprio(1); _Pragma("unroll") for (int m = 0; m < 4; ++m) _Pragma("unroll") for (int n = 0; n < 2; ++n) _Pragma("unroll") for (int k = 0; k < 2; ++k) \
        acc[ai][bj][m][n] = __builtin_amdgcn_mfma_f32_16x16x32_bf16(Bt[n][k], At[m][k], acc[ai][bj][m][n], 0, 0, 0); __builtin_amdgcn_s_setprio(0); } while (0)
#define PG8_WAIT_V(n) asm volatile("s_waitcnt vmcnt(" #n ")" ::: "memory")
#define PG8_WAIT_L(n) asm volatile("s_waitcnt lgkmcnt(" #n ")" ::: "memory")
#define PG8_BAR __builtin_amdgcn_s_barrier()
#define PG8_SCHED __builtin_amdgcn_sched_barrier(0)
    Unit cur, nxt; int ui = 0;
    if (!S.next(0, cur)) return;
    f32x4 acc[2][2][4][2];
#pragma unroll
    for (int a = 0; a < 2; ++a)
#pragma unroll
        for (int b = 0; b < 2; ++b)
#pragma unroll
            for (int m = 0; m < 4; ++m)
#pragma unroll
                for (int n = 0; n < 2; ++n) acc[a][b][m][n] = (f32x4){0.f, 0.f, 0.f, 0.f};
    bf16x8 At[4][2], B0[2][2], B1[2][2];
    const char* cA = S.pa(cur); const char* cB = S.pb(cur);
    PG8_STAGE(PG8_SB(0, 0), cB, voffB); PG8_STAGE(PG8_SB(0, 1), cB + hstepB, voffB); PG8_STAGE(PG8_SA(0, 0), cA, voffA); PG8_STAGE(PG8_SA(0, 1), cA + hstepA, voffA);
    if (wr == 1) PG8_BAR;
    PG8_WAIT_V(2); PG8_BAR;
    PG8_STAGE(PG8_SB(1, 0), cB + kstep, voffB); PG8_STAGE(PG8_SA(1, 0), cA + kstep, voffA); PG8_STAGE(PG8_SB(1, 1), cB + hstepB + kstep, voffB);
    PG8_WAIT_V(6); PG8_BAR;
    for (;;) {
        const bool has_next = S.next(ui + 1, nxt);
        const char* nA = has_next ? S.pa(nxt) : cA; const char* nB = has_next ? S.pb(nxt) : cB;
        for (int t = 0; t < nt; t += 2) {
            const bool last = (t == nt - 2);
            const char* a1 = cA + (size_t)(t + 1) * kstep;
            const char* a2 = last ? nA : cA + (size_t)(t + 2) * kstep; const char* b2 = last ? nB : cB + (size_t)(t + 2) * kstep;
            const char* a3 = a2 + kstep; const char* b3 = b2 + kstep;
            PG8_LDB(B0, 0, 0); PG8_LDB(B1, 0, 1); PG8_SCHED; PG8_LDA(At, 0, 0); PG8_STAGE(PG8_SA(1, 1), a1 + hstepA, voffA);
            PG8_WAIT_V(8); PG8_WAIT_L(0); PG8_BAR; PG8_MMA(0, 0, At, B0); PG8_MMA(0, 1, At, B1); PG8_BAR; PG8_SCHED;
            PG8_LDA(At, 0, 1); PG8_STAGE(PG8_SB(0, 0), b2, voffB); PG8_STAGE(PG8_SB(0, 1), b2 + hstepB, voffB); PG8_STAGE(PG8_SA(0, 0), a2, voffA);
            PG8_WAIT_V(8); PG8_WAIT_L(0); PG8_BAR; PG8_MMA(1, 0, At, B0); PG8_MMA(1, 1, At, B1); PG8_BAR; PG8_SCHED;
            PG8_LDB(B0, 1, 0); PG8_LDB(B1, 1, 1); PG8_SCHED; PG8_LDA(At, 1, 0); PG8_STAGE(PG8_SA(0, 1), a2 + hstepA, voffA);
            PG8_WAIT_V(8); PG8_WAIT_L(0); PG8_BAR; PG8_MMA(0, 0, At, B0); PG8_MMA(0, 1, At, B1); PG8_BAR; PG8_SCHED;
            PG8_LDA(At, 1, 1); PG8_STAGE(PG8_SB(1, 0), b3, voffB); PG8_STAGE(PG8_SB(1, 1), b3 + hstepB, voffB); PG8_STAGE(PG8_SA(1, 0), a3, voffA);
            PG8_WAIT_V(8); PG8_WAIT_L(0); PG8_BAR; PG8_MMA(1, 0, At, B0); PG8_MMA(1, 1, At, B1); PG8_BAR; PG8_SCHED;
        }
        if (wr == 0) PG8_BAR;
        E(acc, cur, wr, wc, fr, fq);
        if (!has_next) break;
#pragma unroll
        for (int a = 0; a < 2; ++a)
#pragma unroll
            for (int b = 0; b < 2; ++b)
#pragma unroll
                for (int m = 0; m < 4; ++m)
#pragma unroll
                    for (int n = 0; n < 2; ++n) acc[a][b][m][n] = (f32x4){0.f, 0.f, 0.f, 0.f};
        cur = nxt; cA = nA; cB = nB; ++ui;
        if (wr == 1) PG8_BAR;
    }
    PG8_WAIT_V(0);
    PG8_BAR;
#undef PG8_SA
#undef PG8_SB
#undef PG8_STAGE
#undef PG8_LDA
#undef PG8_LDB
#undef PG8_MMA
#undef PG8_WAIT_V
#undef PG8_WAIT_L
#undef PG8_BAR
#undef PG8_SCHED
}
}
using pg8::Unit;

struct Params {
    const float* in[25];
    float* out;
    unsigned char* ws;
    int ph_lo, ph_hi;
};
enum { I_XP = 0, I_XS, I_CK, I_CV, I_ST, I_CMK, I_CMV, I_MEM, I_LN0W, I_LN0B, I_WIN, I_WSW, I_WHG, I_WMX, I_SINK, I_LBND, I_HNW, I_WMKV, I_WO, I_LN1W, I_LN1B,
       I_WF1, I_WF2, I_LN2W, I_LN2B };

struct SchedIn {
    int K, lda, G, c; const char* A; const char* B;
    DI int ldb() const { return K; }
    DI bool next(int i, Unit& u) const { const int L = i * G + c; if (L >= 3332) return false;
        if (L < 3300) pg8::swz_tile(L, 132, 25, u.pm, u.pn); else { const int l = L - 3300; u.pm = 132 + (l >> 2); u.pn = 25 + (l & 3); } u.k = 0; return true; }
    DI const char* pa(const Unit& u) const { return A + (size_t)u.pm * (256 * 1024 * 2); }
    DI const char* pb(const Unit& u) const { return B + (size_t)u.pn * (256 * 1024 * 2); }
};
struct SchedUp {
    int K, lda, G, c; const char* A; const char* B;
    DI int ldb() const { return K; }
    DI bool next(int i, Unit& u) const { const int L = (i / 3) * G + c; if (L >= 512) return false; pg8::swz_tile(L, 128, 4, u.pm, u.pn); u.k = i % 3; return true; }
    DI const char* pa(const Unit& u) const { const int co = u.k == 0 ? C_SQ : (u.k == 1 ? C_HQ : C_MQ); return A + (size_t)u.pm * (256 * (size_t)NPJ * 2) + co * 2; }
    DI const char* pb(const Unit& u) const { return B + (size_t)(u.k * 1024 + u.pn * 256) * (512 * 2); }
};
struct SchedUpS {
    int K, lda, pm, pn; const char* A; const char* B;
    DI int ldb() const { return K; }
    DI bool next(int i, Unit& u) const { if (i >= 3) return false; u.pm = pm; u.pn = pn; u.k = i; return true; }
    DI const char* pa(const Unit& u) const { const int co = u.k == 0 ? C_SQ : (u.k == 1 ? C_HQ : C_MQ); return A + (size_t)u.pm * (256 * (size_t)NPJ * 2) + co * 2; }
    DI const char* pb(const Unit& u) const { return B + (size_t)(u.k * 1024 + u.pn * 256) * (512 * 2); }
};
struct SchedOne {
    int K, lda, pm, pn; const char* A; const char* B;
    DI int ldb() const { return K; }
    DI bool next(int i, Unit& u) const { if (i >= 1) return false; u.pm = pm; u.pn = pn; u.k = 0; return true; }
    DI const char* pa(const Unit& u) const { return A + (size_t)u.pm * (256 * (size_t)lda * 2); }
    DI const char* pb(const Unit& u) const { return B + (size_t)u.pn * (256 * (size_t)K * 2); }
};
struct SchedHalfK {
    int K, lda, pm, pn, half; const char* A; const char* B;
    DI int ldb() const { return DFF; }
    DI bool next(int i, Unit& u) const { if (i >= 1) return false; u.pm = pm; u.pn = pn; u.k = half; return true; }
    DI const char* pa(const Unit& u) const { return A + (size_t)u.pm * (256 * (size_t)lda * 2) + (size_t)half * (1408 * 2); }
    DI const char* pb(const Unit& u) const { return B + (size_t)u.pn * (256 * (size_t)DFF * 2) + (size_t)half * (1408 * 2); }
};
struct SchedPlain {
    int K, lda, G, c; const char* A; const char* B; int nM, nN;
    DI int ldb() const { return K; }
    DI bool next(int i, Unit& u) const { const int L = i * G + c; if (L >= nM * nN) return false; pg8::swz_tile(L, nM, nN, u.pm, u.pn); u.k = 0; return true; }
    DI const char* pa(const Unit& u) const { return A + (size_t)u.pm * (256 * (size_t)lda * 2); }
    DI const char* pb(const Unit& u) const { return B + (size_t)u.pn * (256 * (size_t)K * 2); }
};

typedef f32x4 Acc[2][2][4][2];
struct EpiIn {
    bf16_t* proj; float* out; const float* lb; bf16_t* mkb; bf16_t* mvt; bf16_t* vtsw; bf16_t* ksw; int mode;
    DI void operator()(Acc& acc, const Unit& u, int wr, int wc, int fr, int fq) const {
        asm volatile("" : "+v"(fr), "+v"(fq));
        const int pn = u.pn;
        f32x4 lbv[2][2];
        if (u.pm < 132 && (pn == 5 || pn == 6)) {
#pragma unroll
            for (int bj = 0; bj < 2; ++bj) { const int c = (pn - 5) * 256 + bj * 128 + wc * 32 + fq * 8; lbv[bj][0] = *(const f32x4*)(lb + c); lbv[bj][1] = *(const f32x4*)(lb + c + 4); }
        }
        if (u.pm >= 132) {
            const int b = u.pm - 132, kv = (pn - 25) >> 1;
#pragma unroll
            for (int ai = 0; ai < 2; ++ai)
#pragma unroll
                for (int m = 0; m < 4; ++m) { const int s = ai * 128 + wr * 64 + m * 16 + fr;
#pragma unroll
                    for (int bj = 0; bj < 2; ++bj) { const int h = 2 * ((pn - 25) & 1) + bj, d = wc * 32 + fq * 8;
                        const f32x4 v0 = acc[ai][bj][m][0], v1 = acc[ai][bj][m][1];
                        float* o = out + (kv ? O_MVP : O_MKP) + ((size_t)(b * 256 + s) * 4 + h) * 128 + d;
                        *(f32x4*)o = v0; *(f32x4*)(o + 4) = v1;
                        if (kv == 0) *(u32x4*)(mkb + ((((((size_t)(b * 4 + h) * 8 + (s >> 5)) * 8 + (d >> 4)) * 2 + ((d >> 3) & 1)) * 32 + (s & 31)) * 8)) = pack8(v0, v1);
                        else { const int w16 = s & 15; bf16_t* t = mvt + (((((size_t)(b * 4 + h) * 16 + (s >> 4)) * 2 + ((w16 >> 2) & 1)) * 128 + d) * 8) + (w16 & 3) + 4 * (w16 >> 3);
#pragma unroll
                            for (int j = 0; j < 4; ++j) { t[j * 8] = f2bf(v0[j]); t[(4 + j) * 8] = f2bf(v1[j]); } } } }
            return;
        }
#pragma unroll
        for (int ai = 0; ai < 2; ++ai)
#pragma unroll
            for (int m = 0; m < 4; ++m) { const int row = u.pm * 256 + ai * 128 + wr * 64 + m * 16 + fr;
                bf16_t* prow = proj + (size_t)row * NPJ + pn * 256 + wc * 32 + fq * 8;
#pragma unroll
                for (int bj = 0; bj < 2; ++bj) { f32x4 v0 = acc[ai][bj][m][0], v1 = acc[ai][bj][m][1];
                    if (pn == 2) {
                        const int kvh = wc >> 1, d = (wc & 1) * 32 + fq * 8;
                        float* o = nullptr;
                        if (row >= MP) { const int bs = (row - MP) >> 3, t = (row - MP) & 7; o = out + (bj ? O_VWS : O_KWS) + ((size_t)(bs * 128 + 120 + t) * 2 + kvh) * 64 + d; }
                        else { const int t = row & 4095; if (t >= 3968) o = out + (bj ? O_VWP : O_KWP) + ((size_t)((row >> 12) * 128 + t - 3968) * 2 + kvh) * 64 + d; }
                        if (o) { *(f32x4*)o = v0; *(f32x4*)(o + 4) = v1; }
                        if (row < MP) { const int tt = row & 4095, bk = ((row >> 12) * 2 + kvh);
                            if (bj == 0) *(u32x4*)(ksw + ((((((size_t)bk * 128 + (tt >> 5)) * 4 + (d >> 4)) * 2 + ((d >> 3) & 1)) * 32 + (tt & 31)) * 8)) = pack8(v0, v1);
                            else { const int w16 = tt & 15; bf16_t* t = vtsw + (((((size_t)bk * 256 + (tt >> 4)) * 2 + ((w16 >> 2) & 1)) * 64 + d) * 8) + (w16 & 3) + 4 * (w16 >> 3);
#pragma unroll
                                for (int j = 0; j < 4; ++j) { t[j * 8] = f2bf(v0[j]); t[(4 + j) * 8] = f2bf(v1[j]); } } }
                        continue;
                    }
                    if (pn < 2) { v0 *= 0.125f * LOG2E; v1 *= 0.125f * LOG2E; }
                    else if (pn < 5 || (pn >= 9 && pn < 11)) {
#pragma unroll
                        for (int j = 0; j < 4; ++j) { v0[j] = fsilu(v0[j]); v1[j] = fsilu(v1[j]); } }
                    else if (pn < 7) { const f32x4 l0 = lbv[bj][0], l1 = lbv[bj][1];
#pragma unroll
                        for (int j = 0; j < 4; ++j) { v0[j] = flog(l0[j] + (1.0f - l0[j]) * fsigmoid(v0[j])); v1[j] = flog(l1[j] + (1.0f - l1[j]) * fsigmoid(v1[j])); } }
                    else if (pn < 9) {}
                    else if (pn < 13) { v0 *= 0.08838834764831845f * LOG2E; v1 *= 0.08838834764831845f * LOG2E; }
                    else {
#pragma unroll
                        for (int j = 0; j < 4; ++j) { v0[j] = fsigmoid(v0[j]); v1[j] = fsigmoid(v1[j]); } }
                    const u32x4 w8 = pack8(v0, v1);
                    if (mode == 0) *(u32x4*)(prow + bj * 128) = w8; else asm volatile("" :: "v"(w8));
                } }
    }
};
struct EpiUp {
    bf16_t* proj; bool dry;
    DI void operator()(Acc& acc, const Unit& u, int wr, int wc, int fr, int fq) const {
        asm volatile("" : "+v"(fr), "+v"(fq));
        bf16_t* base = proj + (size_t)(u.pm * 256 + wr * 64 + fr) * NPJ + C_GL + u.pn * 256 + wc * 32 + fq * 8;
        {
            u32x4 g[2][4][2];
#pragma unroll
            for (int ai = 0; ai < 2; ++ai)
#pragma unroll
                for (int m = 0; m < 4; ++m)
#pragma unroll
                    for (int bj = 0; bj < 2; ++bj) g[ai][m][bj] = *(const u32x4*)(base + (size_t)(ai * 128 + m * 16) * NPJ + u.k * 1024 + bj * 128);
#pragma unroll
            for (int ai = 0; ai < 2; ++ai)
#pragma unroll
                for (int m = 0; m < 4; ++m)
#pragma unroll
                    for (int bj = 0; bj < 2; ++bj) { const u32x4 q = g[ai][m][bj]; f32x4& v0 = acc[ai][bj][m][0]; f32x4& v1 = acc[ai][bj][m][1];
                        v0[0] *= bflo(q.x); v0[1] *= bfhi(q.x); v0[2] *= bflo(q.y); v0[3] *= bfhi(q.y); v1[0] *= bflo(q.z); v1[1] *= bfhi(q.z); v1[2] *= bflo(q.w); v1[3] *= bfhi(q.w); }
        }
        if (u.k > 0) {
            u32x4 g[2][4][2];
#pragma unroll
            for (int ai = 0; ai < 2; ++ai)
#pragma unroll
                for (int m = 0; m < 4; ++m)
#pragma unroll
                    for (int bj = 0; bj < 2; ++bj) g[ai][m][bj] = *(const u32x4*)(base + (size_t)(ai * 128 + m * 16) * NPJ + bj * 128);
#pragma unroll
            for (int ai = 0; ai < 2; ++ai)
#pragma unroll
                for (int m = 0; m < 4; ++m)
#pragma unroll
                    for (int bj = 0; bj < 2; ++bj) { const u32x4 q = g[ai][m][bj]; f32x4& v0 = acc[ai][bj][m][0]; f32x4& v1 = acc[ai][bj][m][1];
                        v0[0] += bflo(q.x); v0[1] += bfhi(q.x); v0[2] += bflo(q.y); v0[3] += bfhi(q.y); v1[0] += bflo(q.z); v1[1] += bfhi(q.z); v1[2] += bflo(q.w); v1[3] += bfhi(q.w); }
        }
        if (!dry) {
#pragma unroll
            for (int ai = 0; ai < 2; ++ai)
#pragma unroll
                for (int m = 0; m < 4; ++m)
#pragma unroll
                    for (int bj = 0; bj < 2; ++bj) *(u32x4*)(base + (size_t)(ai * 128 + m * 16) * NPJ + bj * 128) = pack8(acc[ai][bj][m][0], acc[ai][bj][m][1]);
        }
    }
};
struct EpiRes {
    bf16_t* proj; const bf16_t* res; int rp;
    DI void operator()(Acc& acc, const Unit& u, int wr, int wc, int fr, int fq) const {
        asm volatile("" : "+v"(fr), "+v"(fq));
        const int row0 = u.pm * 256 + wr * 64 + fr, col0 = u.pn * 256 + wc * 32 + fq * 8;
        u32x4 g[2][4][2];
#pragma unroll
        for (int ai = 0; ai < 2; ++ai)
#pragma unroll
            for (int m = 0; m < 4; ++m)
#pragma unroll
                for (int bj = 0; bj < 2; ++bj) g[ai][m][bj] = *(const u32x4*)(res + (size_t)(row0 + ai * 128 + m * 16) * rp + col0 + bj * 128);
#pragma unroll
        for (int ai = 0; ai < 2; ++ai)
#pragma unroll
            for (int m = 0; m < 4; ++m)
#pragma unroll
                for (int bj = 0; bj < 2; ++bj) { const u32x4 p = g[ai][m][bj]; f32x4 v0 = acc[ai][bj][m][0], v1 = acc[ai][bj][m][1];
                    v0[0] += ALPHA * bflo(p.x); v0[1] += ALPHA * bfhi(p.x); v0[2] += ALPHA * bflo(p.y); v0[3] += ALPHA * bfhi(p.y);
                    v1[0] += ALPHA * bflo(p.z); v1[1] += ALPHA * bfhi(p.z); v1[2] += ALPHA * bflo(p.w); v1[3] += ALPHA * bfhi(p.w);
                    *(u32x4*)(proj + (size_t)(row0 + ai * 128 + m * 16) * NPJ + C_Z + col0 + bj * 128) = pack8(v0, v1); }
    }
};
struct EpiNull {
    DI void operator()(Acc& acc, const Unit& u, int wr, int wc, int fr, int fq) const {
#pragma unroll
        for (int ai = 0; ai < 2; ++ai)
#pragma unroll
            for (int bj = 0; bj < 2; ++bj)
#pragma unroll
                for (int m = 0; m < 4; ++m)
#pragma unroll
                    for (int n = 0; n < 2; ++n) asm volatile("" :: "v"(acc[ai][bj][m][n]));
    }
};
struct EpiPart {
    float* zp;
    DI void operator()(Acc& acc, const Unit& u, int wr, int wc, int fr, int fq) const {
        asm volatile("" : "+v"(fr), "+v"(fq));
#pragma unroll
        for (int ai = 0; ai < 2; ++ai)
#pragma unroll
            for (int m = 0; m < 4; ++m) { float* p = zp + ((size_t)u.k * 1024 + (size_t)(u.pm - 128) * 256 + ai * 128 + wr * 64 + m * 16 + fr) * 1024 + u.pn * 256 + wc * 32 + fq * 8;
#pragma unroll
                for (int bj = 0; bj < 2; ++bj) { *(f32x4*)(p + bj * 128) = acc[ai][bj][m][0]; *(f32x4*)(p + bj * 128 + 4) = acc[ai][bj][m][1]; } }
    }
};
struct EpiGlu {
    bf16_t* proj; int mode;
    DI void operator()(Acc& acc, const Unit& u, int wr, int wc, int fr, int fq) const {
        asm volatile("" : "+v"(fr), "+v"(fq));
#pragma unroll
        for (int ai = 0; ai < 2; ++ai)
#pragma unroll
            for (int m = 0; m < 4; ++m) { const int row = u.pm * 256 + ai * 128 + wr * 64 + m * 16 + fr;
                f32x4 v0, v1;
#pragma unroll
                for (int j = 0; j < 4; ++j) { v0[j] = fsilu(acc[ai][0][m][0][j]) * acc[ai][1][m][0][j]; v1[j] = fsilu(acc[ai][0][m][1][j]) * acc[ai][1][m][1][j]; }
                const u32x4 w8 = pack8(v0, v1);
                if (mode == 0) *(u32x4*)(proj + (size_t)row * NPJ + C_ACT + u.pn * 128 + wc * 32 + fq * 8) = w8; else asm volatile("" :: "v"(w8)); }
    }
};

DI int crow(int reg, int h) { return (reg & 3) + 8 * (reg >> 2) + 4 * h; }
DI bf16x8 pack_step(const f32x16& x, int s) { u32x4 p; p.x = pk2(x[8 * s], x[8 * s + 1]); p.y = pk2(x[8 * s + 2], x[8 * s + 3]); p.z = pk2(x[8 * s + 4], x[8 * s + 5]); p.w = pk2(x[8 * s + 6], x[8 * s + 7]); return __builtin_bit_cast(bf16x8, p); }
#define MFMA32(a, b, c) __builtin_amdgcn_mfma_f32_32x32x16_bf16((a), (b), (c), 0, 0, 0)
#define MFMA16(a, b, c) __builtin_amdgcn_mfma_f32_16x16x32_bf16((a), (b), (c), 0, 0, 0)

template <class T> DI void attn_item(const T& t) {
    constexpr int D = T::D, NCH = T::NCH;
    const int lane = threadIdx.x & 63, r = lane & 31, h = lane >> 5;
    bf16x8 qf[D / 16], kf[D / 16];
#pragma unroll
    for (int kk = 0; kk < D / 16; ++kk) qf[kk] = t.qfrag(r, 16 * kk + 8 * h);
    const int cbeg = t.cbeg();
    if (!T::VSPLIT) {
#pragma unroll
        for (int kk = 0; kk < D / 16; ++kk) kf[kk] = t.kfrag_t(t.tile(cbeg), kk);
    }
    float m = t.m_init(r), l = t.l_init();
    f32x16 o[D / 32];
#pragma unroll
    for (int dd = 0; dd < D / 32; ++dd)
#pragma unroll
        for (int i = 0; i < 16; ++i) o[dd][i] = 0.f;
    bf16x8 vf[2][D / 32];
#pragma unroll 1
    for (int c = cbeg; c < NCH; ++c) {
        const int tl = t.tile(c);
        if (!T::VSPLIT) {
#pragma unroll
            for (int s2 = 0; s2 < 2; ++s2)
#pragma unroll
                for (int dd = 0; dd < D / 32; ++dd) vf[s2][dd] = t.vfrag_t(tl, s2, dd);
        }
        f32x16 s;
        t.init_s(s, tl);
        if (T::VSPLIT) {
#pragma unroll
            for (int kk = 0; kk < D / 16; ++kk) kf[kk] = t.kfrag_t(tl, kk);
        }
#pragma unroll
        for (int kk = 0; kk < D / 16; ++kk) s = MFMA32(kf[kk], qf[kk], s);
        if (!T::VSPLIT && c + 1 < NCH) {
#pragma unroll
            for (int kk = 0; kk < D / 16; ++kk) kf[kk] = t.kfrag_t(tl + 1, kk); }
        t.post_s(s, tl, r, h);
        float mx = s[0];
#pragma unroll
        for (int i = 1; i < 16; ++i) mx = fmaxf(mx, s[i]);
        mx = fmaxf(mx, __shfl_xor(mx, 32));
        const bool need = mx > m + 8.0f;
        if (__builtin_amdgcn_ballot_w64(need) != 0ull) {
            const float mn = need ? mx : m;
            const float sc = fexp2(m - mn);
            l *= sc; m = mn;
#pragma unroll
            for (int dd = 0; dd < D / 32; ++dd)
#pragma unroll
                for (int i = 0; i < 16; ++i) o[dd][i] *= sc;
        }
        float ps = 0.f;
#pragma unroll
        for (int i = 0; i < 16; ++i) { const float p = fexp2(s[i] - m); s[i] = p; ps += p; }
        ps += __shfl_xor(ps, 32);
        l += ps;
#pragma unroll
        for (int s2 = 0; s2 < 2; ++s2) { const bf16x8 pb = pack_step(s, s2);
            if (T::VSPLIT) {
#pragma unroll
                for (int dd = 0; dd < D / 32; ++dd) vf[s2][dd] = t.vfrag_t(tl, s2, dd);
            }
#pragma unroll
            for (int dd = 0; dd < D / 32; ++dd) o[dd] = MFMA32(vf[s2][dd], pb, o[dd]); }
    }
    const float inv = frcp(l);
#pragma unroll
    for (int dd = 0; dd < D / 32; ++dd)
#pragma unroll
        for (int g = 0; g < 4; ++g) { u32x2 w; w.x = pk2(o[dd][4 * g] * inv, o[dd][4 * g + 1] * inv); w.y = pk2(o[dd][4 * g + 2] * inv, o[dd][4 * g + 3] * inv); t.ostore(r, 32 * dd + 8 * g + 4 * h, w); }
}
DI void zero16(f32x16& s) {
#pragma unroll
    for (int i = 0; i < 16; ++i) s[i] = 0.f;
}
struct AttSwP {
    static constexpr int D = 64, NCH = 5; static constexpr bool VSPLIT = false;
    bf16_t* qo; const bf16_t* kb; const bf16_t* vb; int g; float slope2, sink2, lc; bool dry;
    DI AttSwP(bf16_t* proj, const bf16_t* vt, const bf16_t* ks, int b, int hd, int g_, float sl2, float sk2, bool dry_) {
        const int lane = threadIdx.x & 63, r = lane & 31, h = lane >> 5, bk = b * 2 + (hd >> 2);
        qo = proj + (size_t)(b * 4096 + 32 * g_ + r) * NPJ + C_SQ + hd * 64; kb = ks + (size_t)bk * (128 * 2048) + h * 256 + r * 8; vb = vt + (size_t)bk * (256 * 1024) + h * 512 + r * 8;
        g = g_; slope2 = sl2; sink2 = sk2; lc = sl2 * (float)(32 * g_ + r); dry = dry_; }
    DI bf16x8 qfrag(int, int d0) const { return *(const bf16x8*)(qo + d0); }
    DI float m_init(int) const { return sink2; }
    DI float l_init() const { return 1.0f; }
    DI int cbeg() const { return g < 4 ? 4 - g : 0; }
    DI int tile(int c) const { return g - 4 + c; }
    DI bf16x8 kfrag_t(int tl, int kk) const { return *(const bf16x8*)(kb + (size_t)tl * 2048 + kk * 512); }
    DI bf16x8 vfrag_t(int tl, int s2, int dd) const { return *(const bf16x8*)(vb + (size_t)tl * 2048 + s2 * 1024 + dd * 256); }
    DI void init_s(f32x16& s, int tl) const { const int h = (threadIdx.x & 63) >> 5; const float c0 = slope2 * (float)(32 * tl) - lc;
#pragma unroll
        for (int i = 0; i < 16; ++i) s[i] = slope2 * (float)crow(i, h) + c0; }
    DI void post_s(f32x16& s, int tl, int r, int h) const {
        if (tl == g - 4) {
#pragma unroll
            for (int i = 0; i < 16; ++i) s[i] = crow(i, h) > r ? s[i] : -INFINITY; }
        if (tl == g) {
#pragma unroll
            for (int i = 0; i < 16; ++i) s[i] = crow(i, h) <= r ? s[i] : -INFINITY; } }
    DI void ostore(int, int d, u32x2 w) const { if (!dry) *(u32x2*)(qo + d) = w; }
};
struct AttSwS {
    static constexpr int D = 64, NCH = 5; static constexpr bool VSPLIT = true;
    bf16_t* proj; const float* ck; const float* cv; const float* nk; const float* nv; const float* sinks; int b, kvh; bool dry;
    DI bf16x8 qfrag(int r, int d0) const { return *(const bf16x8*)(proj + (size_t)(MP + b * 8 + (r & 7)) * NPJ + C_SQ + (kvh * 4 + (r >> 3)) * 64 + d0); }
    DI float m_init(int r) const { return sinks[kvh * 4 + (r >> 3)] * LOG2E; }
    DI float l_init() const { return 1.0f; }
    DI int cbeg() const { return 0; }
    DI int tile(int c) const { return c; }
    DI const float* krow(const float* c, const float* n, int kk) const { kk = kk > 135 ? 135 : kk; return kk < 128 ? c + ((size_t)(b * 128 + kk) * 2 + kvh) * 64 : n + ((size_t)(b * 128 + kk - 8) * 2 + kvh) * 64; }
    DI bf16x8 kfrag_t(int tl, int kk) const { const int lane = threadIdx.x & 63; return ld8f_bf(krow(ck, nk, 32 * tl + (lane & 31)) + 16 * kk + 8 * (lane >> 5)); }
    DI bf16x8 vfrag_t(int tl, int s2, int dd) const { const int lane = threadIdx.x & 63, d = 32 * dd + (lane & 31), ka = 32 * tl + 16 * s2 + 4 * (lane >> 5); f32x4 a, c;
#pragma unroll
        for (int j = 0; j < 4; ++j) { a[j] = krow(cv, nv, ka + j)[d]; c[j] = krow(cv, nv, ka + 8 + j)[d]; }
        return __builtin_bit_cast(bf16x8, pack8(a, c)); }
    DI void init_s(f32x16& s, int) const { zero16(s); }
    DI void post_s(f32x16& s, int tl, int r, int h) const { const float sl = fexp2(-(float)(kvh * 4 + (r >> 3) + 1)) * LOG2E;
#pragma unroll
        for (int i = 0; i < 16; ++i) { const int dist = 128 + (r & 7) - (32 * tl + crow(i, h)); s[i] = (dist >= 0 && dist < 128) ? s[i] - sl * (float)dist : -INFINITY; } }
    DI void ostore(int r, int d, u32x2 w) const { if (!dry) *(u32x2*)(proj + (size_t)(MP + b * 8 + (r & 7)) * NPJ + C_SQ + (kvh * 4 + (r >> 3)) * 64 + d) = w; }
};
struct AttMemP {
    static constexpr int D = 128, NCH = 8; static constexpr bool VSPLIT = false;
    bf16_t* qo; const bf16_t* kb; const bf16_t* vb; bool dry;
    DI AttMemP(bf16_t* proj, const bf16_t* mk, const bf16_t* mvt, int b, int hd, int g, bool dry_) {
        const int lane = threadIdx.x & 63, r = lane & 31, h = lane >> 5, bh = b * 4 + hd;
        qo = proj + (size_t)(b * 4096 + 32 * g + r) * NPJ + C_MQ + hd * 128; kb = mk + (size_t)bh * (8 * 4096) + h * 256 + r * 8; vb = mvt + (size_t)bh * (16 * 2048) + h * 1024 + r * 8; dry = dry_; }
    DI bf16x8 qfrag(int, int d0) const { return *(const bf16x8*)(qo + d0); }
    DI float m_init(int) const { return -INFINITY; }
    DI float l_init() const { return 0.0f; }
    DI int cbeg() const { return 0; }
    DI int tile(int c) const { return c; }
    DI bf16x8 kfrag_t(int tl, int kk) const { return *(const bf16x8*)(kb + (size_t)tl * 4096 + kk * 512); }
    DI bf16x8 vfrag_t(int tl, int s2, int dd) const { return *(const bf16x8*)(vb + (size_t)tl * 4096 + s2 * 2048 + dd * 256); }
    DI void init_s(f32x16& s, int) const { zero16(s); }
    DI void post_s(f32x16&, int, int, int) const {}
    DI void ostore(int, int d, u32x2 w) const { if (!dry) *(u32x2*)(qo + d) = w; }
};
struct AttMemS {
    static constexpr int D = 128, NCH = 8; static constexpr bool VSPLIT = true;
    bf16_t* proj; const float* mk; const float* mv; int b, hd; bool dry;
    DI bf16x8 qfrag(int r, int d0) const { return *(const bf16x8*)(proj + (size_t)(MP + b * 8 + (r & 7)) * NPJ + C_MQ + hd * 128 + d0); }
    DI float m_init(int) const { return -INFINITY; }
    DI float l_init() const { return 0.0f; }
    DI int cbeg() const { return 0; }
    DI int tile(int c) const { return c; }
    DI bf16x8 kfrag_t(int tl, int kk) const { const int lane = threadIdx.x & 63; return ld8f_bf(mk + ((size_t)(b * 256 + 32 * tl + (lane & 31)) * 4 + hd) * 128 + 16 * kk + 8 * (lane >> 5)); }
    DI bf16x8 vfrag_t(int tl, int s2, int dd) const { const int lane = threadIdx.x & 63; const float* p = mv + ((size_t)(b * 256 + 32 * tl + 16 * s2 + 4 * (lane >> 5)) * 4 + hd) * 128 + 32 * dd + (lane & 31); f32x4 a, c;
#pragma unroll
        for (int j = 0; j < 4; ++j) { a[j] = p[(size_t)j * 512]; c[j] = p[(size_t)(8 + j) * 512]; }
        return __builtin_bit_cast(bf16x8, pack8(a, c)); }
    DI void init_s(f32x16& s, int) const { zero16(s); }
    DI void post_s(f32x16&, int, int, int) const {}
    DI void ostore(int r, int d, u32x2 w) const { if (r < 8 && !dry) *(u32x2*)(proj + (size_t)(MP + b * 8 + r) * NPJ + C_MQ + hd * 128 + d) = w; }
};

constexpr int HQ_OFF = 0, HK_OFF = 17408, HKT_OFF = 34816, HVT_OFF = 53248, HA_OFF = 71680, HD_OFF = 80896, HBP_OFF = 81408, HSS_OFF = 83456, HRS_OFF = 85504;
constexpr int HOB_OFF = 85760, OBP = 132;
constexpr int QP = 136, TP = 72;
template <bool OUT> DI void hgrn_item(LAS unsigned char* lds, bf16_t* proj, float* hst, float* hdv, const float* normw, int item, bool dry) {
    const int tid = threadIdx.x, lane = tid & 63, w = __builtin_amdgcn_readfirstlane(tid >> 6);
    const int b = item >> 6, h = (item >> 4) & 3, c = item & 15;
    const int d = tid & 127, tq = tid >> 7;
    LAS bf16_t* Qt = (LAS bf16_t*)(lds + HQ_OFF); LAS bf16_t* Kt = (LAS bf16_t*)(lds + HK_OFF); LAS bf16_t* KtT = (LAS bf16_t*)(lds + HKT_OFF);
    LAS bf16_t* VT = (LAS bf16_t*)(lds + HVT_OFF); LAS bf16_t* Ab = (LAS bf16_t*)(lds + HA_OFF);
    LAS float* Dv = (LAS float*)(lds + HD_OFF); LAS float* bpart = (LAS float*)(lds + HBP_OFF); LAS float* ssq = (LAS float*)(lds + HSS_OFF); LAS float* rsd = (LAS float*)(lds + HRS_OFF);
    const int e16 = lane & 15, rq = lane >> 4;
    f32x4 st[8];
    float* hs = hst + (size_t)item * 16384 + (size_t)(w * 8) * 256 + lane * 4;
    if (OUT) {
#pragma unroll
        for (int i = 0; i < 8; ++i) st[i] = *(const f32x4*)(hs + i * 256);
    } else {
#pragma unroll
        for (int i = 0; i < 8; ++i) st[i] = (f32x4){0.f, 0.f, 0.f, 0.f};
    }
    float btot = 0.f;
    unsigned rg[8], rqv[8], rvv[8];
#define HG_LOAD(SC) do { const size_t r0_ = (size_t)b * 4096 + c * 256 + (SC) * 64 + tq * 16; const bf16_t* pg_ = proj + r0_ * NPJ + h * 128 + d; \
        _Pragma("unroll") for (int i = 0; i < 8; ++i) { const bf16_t* p0_ = pg_ + (size_t)(2 * i) * NPJ; const bf16_t* p1_ = p0_ + NPJ; \
            rg[i] = (unsigned)p0_[C_HF] | ((unsigned)p1_[C_HF] << 16); rvv[i] = (unsigned)p0_[C_HI] | ((unsigned)p1_[C_HI] << 16); \
            if (OUT) rqv[i] = (unsigned)p0_[C_HQ] | ((unsigned)p1_[C_HQ] << 16); } } while (0)
    HG_LOAD(0);
#pragma unroll 1
    for (int sc = 0; sc < 4; ++sc) {
        const size_t row0 = (size_t)b * 4096 + c * 256 + sc * 64;
        float gl[16], qv[16];
#pragma unroll
        for (int i = 0; i < 8; ++i) { gl[2 * i] = bflo(rg[i]); gl[2 * i + 1] = bfhi(rg[i]); if (OUT) { qv[2 * i] = bflo(rqv[i]); qv[2 * i + 1] = bfhi(rqv[i]); } }
        *(LAS u32x4*)(VT + d * TP + tq * 16) = (u32x4){rvv[0], rvv[1], rvv[2], rvv[3]};
        *(LAS u32x4*)(VT + d * TP + tq * 16 + 8) = (u32x4){rvv[4], rvv[5], rvv[6], rvv[7]};
        if (sc < 3) HG_LOAD(sc + 1);
        float run = 0.f;
        float bl[16];
#pragma unroll
        for (int i = 0; i < 16; ++i) { run += gl[i]; bl[i] = run; }
        bpart[tq * 128 + d] = run;
        __syncthreads();
        float off = 0.f, tot = 0.f;
#pragma unroll
        for (int q = 0; q < 4; ++q) { const float p = bpart[q * 128 + d]; tot += p; if (q < tq) off += p; }
        btot += tot;
        if (tq == 0) Dv[d] = fexp(tot);
        {
            unsigned kk[8];
#pragma unroll
            for (int i = 0; i < 8; ++i) {
                const float b0 = off + bl[2 * i], b1 = off + bl[2 * i + 1];
                const float k0 = (1.0f - fexp(gl[2 * i])) * fexp(-b0), k1 = (1.0f - fexp(gl[2 * i + 1])) * fexp(-b1);
                kk[i] = pk2(k0, k1);
                if (OUT) { Kt[(tq * 16 + 2 * i) * QP + d] = (bf16_t)(kk[i] & 0xffffu); Kt[(tq * 16 + 2 * i + 1) * QP + d] = (bf16_t)(kk[i] >> 16);
                    Qt[(tq * 16 + 2 * i) * QP + d] = f2bf(qv[2 * i] * fexp(b0)); Qt[(tq * 16 + 2 * i + 1) * QP + d] = f2bf(qv[2 * i + 1] * fexp(b1)); }
            }
            *(LAS u32x4*)(KtT + d * TP + tq * 16) = (u32x4){kk[0], kk[1], kk[2], kk[3]};
            *(LAS u32x4*)(KtT + d * TP + tq * 16 + 8) = (u32x4){kk[4], kk[5], kk[6], kk[7]};
        }
        __syncthreads();
        f32x4 o[4];
        bf16x8 vfr[2];
#pragma unroll
        for (int ks = 0; ks < 2; ++ks) vfr[ks] = *(const LAS bf16x8*)(VT + (w * 16 + e16) * TP + 32 * ks + 8 * rq);
        if (OUT) {
#pragma unroll
            for (int u = 0; u < 2; ++u) { const int id = w + 8 * u, ti = id >> 2, sj = id & 3;
                f32x4 a = {0.f, 0.f, 0.f, 0.f};
                if (sj <= ti) {
#pragma unroll
                    for (int ks = 0; ks < 4; ++ks) { const bf16x8 qa = *(const LAS bf16x8*)(Qt + (16 * ti + e16) * QP + 32 * ks + 8 * rq), kb = *(const LAS bf16x8*)(Kt + (16 * sj + e16) * QP + 32 * ks + 8 * rq);
                        a = MFMA16(qa, kb, a); }
                }
#pragma unroll
                for (int r = 0; r < 4; ++r) { const int tt = 16 * ti + 4 * rq + r, ss = 16 * sj + e16; Ab[tt * TP + ss] = (sj <= ti && ss <= tt) ? f2bf(a[r]) : (bf16_t)0; }
            }
#pragma unroll
            for (int ti = 0; ti < 4; ++ti) { o[ti] = (f32x4){0.f, 0.f, 0.f, 0.f};
#pragma unroll
                for (int ks = 0; ks < 4; ++ks) { const LAS bf16_t* qp = Qt + (16 * ti + e16) * QP + 32 * ks + 4 * rq; const u32x2 q0 = *(const LAS u32x2*)qp, q1 = *(const LAS u32x2*)(qp + 16);
                    u32x4 qa = {q0.x, q0.y, q1.x, q1.y};
                    u32x4 sb; sb.x = pk2(st[2 * ks][0], st[2 * ks][1]); sb.y = pk2(st[2 * ks][2], st[2 * ks][3]); sb.z = pk2(st[2 * ks + 1][0], st[2 * ks + 1][1]); sb.w = pk2(st[2 * ks + 1][2], st[2 * ks + 1][3]);
                    o[ti] = MFMA16(__builtin_bit_cast(bf16x8, qa), __builtin_bit_cast(bf16x8, sb), o[ti]); } }
        }
#pragma unroll
        for (int dt = 0; dt < 8; ++dt) {
#pragma unroll
            for (int ks = 0; ks < 2; ++ks) { const bf16x8 ka = *(const LAS bf16x8*)(KtT + (16 * dt + e16) * TP + 32 * ks + 8 * rq); st[dt] = MFMA16(ka, vfr[ks], st[dt]); }
            const f32x4 dv = *(const LAS f32x4*)(Dv + 16 * dt + 4 * rq);
            st[dt] *= dv;
        }
        u32x4 gate8[2];
        if (OUT) {
#pragma unroll
            for (int j = 0; j < 2; ++j) { const int cch = tid + 512 * j; gate8[j] = *(const u32x4*)(proj + (row0 + (cch >> 4)) * NPJ + C_HG + h * 128 + 8 * (cch & 15)); }
        }
        __syncthreads();
        if (OUT) {
#pragma unroll
            for (int ti = 0; ti < 4; ++ti)
#pragma unroll
                for (int ks = 0; ks < 2; ++ks) if (2 * ks <= ti) { const bf16x8 aa = *(const LAS bf16x8*)(Ab + (16 * ti + e16) * TP + 32 * ks + 8 * rq); o[ti] = MFMA16(aa, vfr[ks], o[ti]); }
            LAS float* Ob = (LAS float*)(lds + HOB_OFF);
#pragma unroll
            for (int ti = 0; ti < 4; ++ti)
#pragma unroll
                for (int r = 0; r < 4; ++r) Ob[(16 * ti + 4 * rq + r) * OBP + w * 16 + e16] = o[ti][r];
            __syncthreads();
#pragma unroll
            for (int j = 0; j < 2; ++j) { const int cch = tid + 512 * j, tt = cch >> 4, e0 = 8 * (cch & 15);
                const f32x4 a0 = *(const LAS f32x4*)(Ob + tt * OBP + e0), a1 = *(const LAS f32x4*)(Ob + tt * OBP + e0 + 4);
                float q = (a0[0] * a0[0] + a0[1] * a0[1]) + (a0[2] * a0[2] + a0[3] * a0[3]) + (a1[0] * a1[0] + a1[1] * a1[1]) + (a1[2] * a1[2] + a1[3] * a1[3]);
                q += __shfl_xor(q, 1); q += __shfl_xor(q, 2); q += __shfl_xor(q, 4); q += __shfl_xor(q, 8);
                const float rs = __builtin_amdgcn_rsqf(q * (1.0f / 128.0f) + 1e-6f);
                const f32x4 n0 = *(const f32x4*)(normw + e0), n1 = *(const f32x4*)(normw + e0 + 4); const u32x4 g = gate8[j];
                f32x4 y0, y1;
                y0[0] = a0[0] * rs * n0[0] * bflo(g.x); y0[1] = a0[1] * rs * n0[1] * bfhi(g.x); y0[2] = a0[2] * rs * n0[2] * bflo(g.y); y0[3] = a0[3] * rs * n0[3] * bfhi(g.y);
                y1[0] = a1[0] * rs * n1[0] * bflo(g.z); y1[1] = a1[1] * rs * n1[1] * bfhi(g.z); y1[2] = a1[2] * rs * n1[2] * bflo(g.w); y1[3] = a1[3] * rs * n1[3] * bfhi(g.w);
                if (!dry) *(u32x4*)(proj + (row0 + tt) * NPJ + C_HQ + h * 128 + e0) = pack8(y0, y1); }
        }
    }
    if (!OUT) {
#pragma unroll
        for (int i = 0; i < 8; ++i) *(f32x4*)(hs + i * 256) = st[i];
        if (tq == 0) hdv[(size_t)item * 128 + d] = fexp(btot);
    }
}
DI void hgrn_scan(float* hst, const float* hdv, float* out, int gt, bool dry) {
    const int bh = gt >> 12, rem = gt & 4095, w = rem >> 9, tile = (rem >> 6) & 7, lane = rem & 63;
    const int d0 = 16 * tile + 4 * (lane >> 4), e = 16 * w + (lane & 15);
    f32x4 S = {0.f, 0.f, 0.f, 0.f};
#pragma unroll 4
    for (int c = 0; c < 16; ++c) { const int item = bh * 16 + c; float* p = hst + (size_t)item * 16384 + (size_t)(w * 8 + tile) * 256 + lane * 4;
        const f32x4 loc = *(const f32x4*)p; const f32x4 dv = *(const f32x4*)(hdv + (size_t)item * 128 + d0);
        if (!dry) *(f32x4*)p = S; S = dv * S + loc; }
#pragma unroll
    for (int r = 0; r < 4; ++r) out[O_SP + ((size_t)bh * 128 + d0 + r) * 128 + e] = S[r];
}
DI void hgrn_sample_item(LAS unsigned char* lds, bf16_t* proj, const float* state, float* out, const float* normw, int item, bool dry) {
    const int tid = threadIdx.x, lane = tid & 63, w = tid >> 6;
    const int b = item >> 2, h = item & 3, e = tid & 127, dq = tid >> 7;
    LAS float* F = (LAS float*)lds;
    LAS float* Kk = F + 1024;
    LAS float* Q = Kk + 1024;
    LAS float* V = Q + 1024;
    LAS float* OP = V + 1024;
    for (int i = tid; i < 1024; i += 512) { const int t = i >> 7, dd = i & 127; const bf16_t* pr = proj + (size_t)(MP + b * 8 + t) * NPJ + h * 128 + dd;
        const float f = fexp(bf2f(pr[C_HF])); F[i] = f; Kk[i] = 1.0f - f; Q[i] = bf2f(pr[C_HQ]); V[i] = bf2f(pr[C_HI]); }
    float S[32];
    const float* sp = state + ((size_t)(b * 4 + h) * 128 + dq * 32) * 128 + e;
#pragma unroll
    for (int i = 0; i < 32; ++i) S[i] = sp[(size_t)i * 128];
    __syncthreads();
#pragma unroll 1
    for (int t = 0; t < 8; ++t) { const float v = V[t * 128 + e]; float op = 0.f;
#pragma unroll
        for (int i = 0; i < 32; ++i) { const int dd = dq * 32 + i; S[i] = F[t * 128 + dd] * S[i] + Kk[t * 128 + dd] * v; op += Q[t * 128 + dd] * S[i]; }
        OP[(t * 4 + dq) * 128 + e] = op; }
    float* so = out + O_SS + ((size_t)(b * 4 + h) * 128 + dq * 32) * 128 + e;
#pragma unroll
    for (int i = 0; i < 32; ++i) so[(size_t)i * 128] = S[i];
    __syncthreads();
    {
        const int t = w; float o0 = 0.f, o1 = 0.f;
#pragma unroll
        for (int q = 0; q < 4; ++q) { o0 += OP[(t * 4 + q) * 128 + lane]; o1 += OP[(t * 4 + q) * 128 + 64 + lane]; }
        float ss = o0 * o0 + o1 * o1;
#pragma unroll
        for (int x = 1; x < 64; x <<= 1) ss += __shfl_xor(ss, x);
        const float rs = __builtin_amdgcn_rsqf(ss * (1.0f / 128.0f) + 1e-6f);
        bf16_t* pr = proj + (size_t)(MP + b * 8 + t) * NPJ + h * 128;
        const float g0 = bf2f(pr[C_HG + lane]), g1 = bf2f(pr[C_HG + 64 + lane]);
        __syncthreads();
        if (!dry) { pr[C_HQ + lane] = f2bf(o0 * rs * normw[lane] * g0); pr[C_HQ + 64 + lane] = f2bf(o1 * rs * normw[64 + lane] * g1); }
    }
    __syncthreads();
}

DI float wave_sum(float v) {
#pragma unroll
    for (int o = 1; o < 64; o <<= 1) v += __shfl_xor(v, o);
    return v;
}
DI void transpose_item(const float* W, int K, int N, bf16_t* WT, int k0, int n0, int drow0, LAS float* scr, int lane) {
#pragma unroll 8
    for (int i = 0; i < 32; ++i) { const int kk = 2 * i + (lane >> 5); scr[kk * 33 + (lane & 31)] = W[(size_t)(k0 + kk) * N + n0 + (lane & 31)]; }
    asm volatile("s_waitcnt lgkmcnt(0)" ::: "memory");
    const int c = lane & 7;
#pragma unroll
    for (int j = 0; j < 4; ++j) { const int n = (lane >> 3) + 8 * j; const LAS float* s = scr + (8 * c) * 33 + n;
        u32x4 o; o.x = pk2(s[0 * 33], s[1 * 33]); o.y = pk2(s[2 * 33], s[3 * 33]); o.z = pk2(s[4 * 33], s[5 * 33]); o.w = pk2(s[6 * 33], s[7 * 33]);
        *(u32x4*)(WT + (size_t)(drow0 + n) * K + k0 + 8 * c) = o; }
    asm volatile("s_waitcnt lgkmcnt(0)" ::: "memory");
}
DI void ln_row_f32_to_bf16(const float* x, const float* w, const float* bb, bf16_t* o, int lane) {
    const f32x4* xr = (const f32x4*)x + lane; f32x4 v[4]; float s = 0.f;
#pragma unroll
    for (int j = 0; j < 4; ++j) { v[j] = xr[64 * j]; s += (v[j][0] + v[j][1]) + (v[j][2] + v[j][3]); }
    const float mean = wave_sum(s) * (1.f / 1024.f); float s2 = 0.f;
#pragma unroll
    for (int j = 0; j < 4; ++j) { v[j] = v[j] - mean; s2 += (v[j][0] * v[j][0] + v[j][1] * v[j][1]) + (v[j][2] * v[j][2] + v[j][3] * v[j][3]); }
    const float rstd = __builtin_amdgcn_rsqf(wave_sum(s2) * (1.f / 1024.f) + 1e-5f);
#pragma unroll
    for (int j = 0; j < 4; ++j) { const f32x4 ww = ((const f32x4*)w)[64 * j + lane], bv = ((const f32x4*)bb)[64 * j + lane]; const f32x4 y = v[j] * rstd * ww + bv;
        u32x2 p; p.x = pk2(y[0], y[1]); p.y = pk2(y[2], y[3]); ((u32x2*)o)[64 * j + lane] = p; }
}
template <bool F32OUT> DI void ln_row_bf16(const bf16_t* z, const float* w, const float* bb, void* o, int lane) {
    float v[16]; float s = 0.f;
#pragma unroll
    for (int j = 0; j < 2; ++j) { const u32x4 p = *(const u32x4*)(z + 512 * j + 8 * lane);
        v[8 * j + 0] = bflo(p.x); v[8 * j + 1] = bfhi(p.x); v[8 * j + 2] = bflo(p.y); v[8 * j + 3] = bfhi(p.y); v[8 * j + 4] = bflo(p.z); v[8 * j + 5] = bfhi(p.z); v[8 * j + 6] = bflo(p.w); v[8 * j + 7] = bfhi(p.w); }
#pragma unroll
    for (int i = 0; i < 16; ++i) s += v[i];
    const float mean = wave_sum(s) * (1.f / 1024.f); float s2 = 0.f;
#pragma unroll
    for (int i = 0; i < 16; ++i) { v[i] -= mean; s2 += v[i] * v[i]; }
    const float rstd = __builtin_amdgcn_rsqf(wave_sum(s2) * (1.f / 1024.f) + 1e-5f);
#pragma unroll
    for (int j = 0; j < 2; ++j) { const int c = 512 * j + 8 * lane; const f32x4 w0 = *(const f32x4*)(w + c), w1 = *(const f32x4*)(w + c + 4), b0 = *(const f32x4*)(bb + c), b1 = *(const f32x4*)(bb + c + 4);
        f32x4 y0, y1;
#pragma unroll
        for (int i = 0; i < 4; ++i) { y0[i] = v[8 * j + i] * rstd * w0[i] + b0[i]; y1[i] = v[8 * j + 4 + i] * rstd * w1[i] + b1[i]; }
        if (F32OUT) { *(f32x4*)((float*)o + c) = y0; *(f32x4*)((float*)o + c + 4) = y1; }
        else *(u32x4*)((bf16_t*)o + c) = pack8(y0, y1); }
}

#define XB_TMO      128
#define XB_XCNT(j)  (256  + 64 * (j))
#define XB_XSUB(j)  (1280 + 64 * (j))
#define XB_XGEN(j)  (2304 + 64 * (j))
#define XB_TOP      3328
#define XB_TOPGEN   3392
#define XCD_BAR_WORDS 3456
#define XB_SPIN_CAP (1u << 18)

__device__ __forceinline__ unsigned xb_ld(unsigned* p)              { return __hip_atomic_load(p, __ATOMIC_RELAXED, __HIP_MEMORY_SCOPE_AGENT); }
__device__ __forceinline__ unsigned xb_add(unsigned* p, unsigned v) { return __hip_atomic_fetch_add(p, v, __ATOMIC_RELAXED, __HIP_MEMORY_SCOPE_AGENT); }
__device__ __forceinline__ unsigned xb_xcc_id() { return (unsigned)__builtin_amdgcn_s_getreg((3 << 11) | 20) & 0xFu; }
#define XB_SPIN(cond, bar) do { unsigned _sp = 0; while (cond) { __builtin_amdgcn_s_sleep(1); \
    if ((++_sp & 255u) == 0u) { if (xb_ld(&(bar)[XB_TMO])) break; if (_sp > XB_SPIN_CAP) { atomicAdd(&(bar)[XB_TMO], 1u); break; } } } } while (0)

struct XcdBarrier {
    unsigned* bar; unsigned x;
    volatile LAS unsigned* st;
};

__device__ __forceinline__ XcdBarrier xcd_barrier_post(unsigned* bar, volatile LAS unsigned* st) {
    XcdBarrier b; b.bar = bar; b.x = xb_xcc_id(); b.st = st;
    if (threadIdx.x == 0) (void)xb_add(&bar[XB_XCNT(b.x)], 1u);
    return b;
}
__device__ __forceinline__ void xcd_barrier_complete(unsigned* bar, unsigned x, unsigned& nloc, unsigned& nx) {
    const unsigned G = gridDim.x * gridDim.y * gridDim.z;
    unsigned sum, cnt, mine, sp = 0u;
    for (;;) {
        sum = 0u; cnt = 0u; mine = 0u;
#pragma unroll
        for (unsigned j = 0; j < 16; ++j) { const unsigned c = xb_ld(&bar[XB_XCNT(j)]); sum += c; cnt += (c > 0u) ? 1u : 0u; mine = (j == x) ? c : mine; }
        if (sum == G) break;
        __builtin_amdgcn_s_sleep(1);
        if ((++sp & 255u) == 0u) { if (xb_ld(&bar[XB_TMO])) break; if (sp > XB_SPIN_CAP) { atomicAdd(&bar[XB_TMO], 1u); break; } }
    }
    nloc = mine > 0u ? mine : 1u; nx = cnt > 0u ? cnt : 1u;
}

__device__ __forceinline__ void xcd_barrier(const XcdBarrier& b) {
    asm volatile("s_waitcnt vmcnt(0)" ::: "memory");
    __syncthreads();
    if (threadIdx.x == 0) {
        unsigned* bar = b.bar;
        __builtin_amdgcn_s_waitcnt(0);
        unsigned nloc = b.st[0], nx = b.st[1];
        if (nloc == 0u) { xcd_barrier_complete(bar, b.x, nloc, nx); b.st[0] = nloc; b.st[1] = nx; }
        const unsigned old = xb_add(&bar[XB_XSUB(b.x)], 1u);
        const unsigned gen = old / nloc;
        if (old + 1u == (gen + 1u) * nloc) {
            __builtin_amdgcn_fence(__ATOMIC_RELEASE, "agent");
            asm volatile("s_waitcnt vmcnt(0)" ::: "memory");
            const unsigned og = xb_add(&bar[XB_TOP], 1u);
            const unsigned tg = og / nx;
            if (og + 1u == (tg + 1u) * nx) xb_add(&bar[XB_TOPGEN], 1u);
            else XB_SPIN(xb_ld(&bar[XB_TOPGEN]) == tg, bar);
            __builtin_amdgcn_fence(__ATOMIC_ACQUIRE, "agent");
            xb_add(&bar[XB_XGEN(b.x)], 1u);
            asm volatile("s_waitcnt vmcnt(0)" ::: "memory");
        } else {
            XB_SPIN(xb_ld(&bar[XB_XGEN(b.x)]) == gen, bar);
            __builtin_amdgcn_fence(__ATOMIC_ACQUIRE, "agent");
            asm volatile("s_waitcnt vmcnt(0)" ::: "memory");
        }
    }
    __syncthreads();
}


DI void ln_row_sample(const bf16_t* hrow, const float* z0, const float* z1, const float* w, const float* bb, float* o, int lane) {
    float v[16]; float s = 0.f;
#pragma unroll
    for (int j = 0; j < 2; ++j) { const int c = 512 * j + 8 * lane; const u32x4 p = *(const u32x4*)(hrow + c);
        const f32x4 a0 = *(const f32x4*)(z0 + c), a1 = *(const f32x4*)(z0 + c + 4), b0 = *(const f32x4*)(z1 + c), b1 = *(const f32x4*)(z1 + c + 4);
        v[8 * j + 0] = ALPHA * bflo(p.x) + a0[0] + b0[0]; v[8 * j + 1] = ALPHA * bfhi(p.x) + a0[1] + b0[1]; v[8 * j + 2] = ALPHA * bflo(p.y) + a0[2] + b0[2]; v[8 * j + 3] = ALPHA * bfhi(p.y) + a0[3] + b0[3];
        v[8 * j + 4] = ALPHA * bflo(p.z) + a1[0] + b1[0]; v[8 * j + 5] = ALPHA * bfhi(p.z) + a1[1] + b1[1]; v[8 * j + 6] = ALPHA * bflo(p.w) + a1[2] + b1[2]; v[8 * j + 7] = ALPHA * bfhi(p.w) + a1[3] + b1[3]; }
#pragma unroll
    for (int i = 0; i < 16; ++i) s += v[i];
    const float mean = wave_sum(s) * (1.f / 1024.f); float s2 = 0.f;
#pragma unroll
    for (int i = 0; i < 16; ++i) { v[i] -= mean; s2 += v[i] * v[i]; }
    const float rstd = __builtin_amdgcn_rsqf(wave_sum(s2) * (1.f / 1024.f) + 1e-5f);
#pragma unroll
    for (int j = 0; j < 2; ++j) { const int c = 512 * j + 8 * lane; const f32x4 w0 = *(const f32x4*)(w + c), w1 = *(const f32x4*)(w + c + 4), b0 = *(const f32x4*)(bb + c), b1 = *(const f32x4*)(bb + c + 4);
        f32x4 y0, y1;
#pragma unroll
        for (int i = 0; i < 4; ++i) { y0[i] = v[8 * j + i] * rstd * w0[i] + b0[i]; y1[i] = v[8 * j + 4 + i] * rstd * w1[i] + b1[i]; }
        *(f32x4*)(o + c) = y0; *(f32x4*)(o + c + 4) = y1; }
}
constexpr int LDS_BYTES = 131072 + 1024;
__global__ void __launch_bounds__(512, 2) fwd_kernel(Params P) {
    extern __shared__ __attribute__((aligned(16))) unsigned char lds_raw[];
    LAS unsigned char* lds = (LAS unsigned char*)lds_raw;
    cg::grid_group grid = cg::this_grid();
    volatile LAS unsigned* bst = (volatile LAS unsigned*)(lds + 131072 + 512);
    if (threadIdx.x < 2) bst[threadIdx.x] = 0u;
    __syncthreads();
    XcdBarrier xbar = xcd_barrier_post((unsigned*)(P.ws + W_BAR), bst);
    const int tid = threadIdx.x, lane = tid & 63, wave = __builtin_amdgcn_readfirstlane(tid >> 6);
    const int G = gridDim.x, cu = blockIdx.x;
    const int gw = cu * 8 + wave, NGW = G * 8;
    unsigned char* sc = (unsigned char*)P.out;
    bf16_t* WT_IN = (bf16_t*)(sc + S_WTIN); bf16_t* WT_UP = (bf16_t*)(sc + S_WTUP); bf16_t* WT_O = (bf16_t*)(sc + S_WTO); bf16_t* WT_F1 = (bf16_t*)(sc + S_WTF1); bf16_t* WT_F2 = (bf16_t*)(sc + S_WTF2);
    bf16_t* XN = (bf16_t*)(sc + S_XN); bf16_t* MKB = (bf16_t*)(sc + S_MKB); bf16_t* MVT = (bf16_t*)(sc + S_MVT); bf16_t* VTSW = (bf16_t*)(sc + S_VTSW); bf16_t* KSW = (bf16_t*)(sc + S_KSW); float* LB = (float*)(sc + S_LB);
    bf16_t* PROJ = (bf16_t*)(P.ws + W_PROJ); float* HST = (float*)(P.ws + W_HST); float* HDV = (float*)(P.ws + W_HD);
    const int lo = P.ph_lo, hi = P.ph_hi;
#ifndef ATT_MASK
#define ATT_MASK 15
#endif
#ifndef PHASE_MASK
#define PHASE_MASK 0x1fff
#endif
#define IN(k) (((PHASE_MASK >> (k)) & 1) && lo <= (k) && (k) < hi)
#ifndef DUP_MASK
#define DUP_MASK 0
#endif
#ifndef PROBE_P8
#define PROBE_P8 0
#endif
#ifndef PROBE_P1
#define PROBE_P1 0
#endif
#ifndef ATT_DRY_MASK
#define ATT_DRY_MASK 31
#endif
#define REPS(k) for (int rep_ = 0, nrep_ = 1 + ((DUP_MASK >> (k)) & 1); rep_ < nrep_; ++rep_)
#define DRY (rep_ + 1 < nrep_)
#define SEAM(k) do { if (IN(k) && IN((k) + 1)) { if (P.ph_lo < 0) grid.sync(); else xcd_barrier(xbar); } } while (0)

    if (IN(0)) REPS(0) {
        LAS float* scr = (LAS float*)(lds + wave * 8704);
        constexpr int IT_IN = 16 * 200, IT_MKV = 16 * 32, IT_UP = 8 * 32, IT_O = 16 * 32, IT_F1 = 16 * 176, IT_F2 = 44 * 32;
        constexpr int NIT = IT_IN + IT_MKV;
        for (int it = gw; it < NIT; it += NGW) {
            int r = it;
            if (r < IT_IN) { const int kb = r / 200, nb = r % 200; transpose_item(P.in[I_WIN], 1024, 6400, WT_IN, 64 * kb, 32 * nb, 32 * nb, scr, lane); continue; } r -= IT_IN;
            { const int kb = r / 32, nb = r % 32; transpose_item(P.in[I_WMKV], 1024, 1024, WT_IN, 64 * kb, 32 * nb, 6400 + 32 * nb, scr, lane); }
        }
        for (int m = gw; m < MT; m += NGW) { const float* x = m < MP ? P.in[I_XP] + (size_t)m * 1024 : P.in[I_XS] + (size_t)(m - MP) * 1024; ln_row_f32_to_bf16(x, P.in[I_LN0W], P.in[I_LN0B], XN + (size_t)m * 1024, lane); }
        for (int m = gw; m < 2048; m += NGW) { const f32x4* xr = (const f32x4*)(P.in[I_MEM] + (size_t)m * 1024) + lane; u32x2* o = (u32x2*)(XN + (size_t)(MT + m) * 1024) + lane;
#pragma unroll
            for (int j = 0; j < 4; ++j) { const f32x4 v = xr[64 * j]; u32x2 p; p.x = pk2(v[0], v[1]); p.y = pk2(v[2], v[3]); o[64 * j] = p; } }
        if (cu == 0) { const float a0 = P.in[I_LBND][tid], a1 = P.in[I_LBND][512 + tid]; LB[tid] = frcp(1.0f + fexp(a1 - a0)); }
    }
    SEAM(0);
    if (IN(1)) REPS(1) {
        SchedIn S{1024, 1024, G, cu, (const char*)XN, (const char*)WT_IN};
#if PROBE_P1 == 1
        if (DRY) { EpiNull E0; pg8::gemm_phase(lds, S, E0); } else
#elif PROBE_P1 == 2
        if (DRY) { EpiIn E0{PROJ, P.out, LB, MKB, MVT, VTSW, KSW, 1}; pg8::gemm_phase(lds, S, E0); } else
#endif
        { EpiIn E{PROJ, P.out, LB, MKB, MVT, VTSW, KSW, 0}; pg8::gemm_phase(lds, S, E); }
        if (cu >= 4) {
            LAS float* scr = (LAS float*)(lds + wave * 8704);
            constexpr int IT_UP = 8 * 32, IT_O = 16 * 32, IT_F1 = 16 * 176, IT_F2 = 44 * 32, NIT1 = 3 * IT_UP + IT_O + IT_F1 + IT_F2;
            for (int it = (cu - 4) * 8 + wave; it < NIT1; it += (G - 4) * 8) {
                int r = it;
                if (r < 3 * IT_UP) { const int k = r / IT_UP, q = r % IT_UP, kb = q / 32, nb = q % 32; transpose_item(P.in[I_WSW + k], 512, 1024, WT_UP + (size_t)k * 1024 * 512, 64 * kb, 32 * nb, 32 * nb, scr, lane); continue; } r -= 3 * IT_UP;
                if (r < IT_O) { const int kb = r / 32, nb = r % 32; transpose_item(P.in[I_WO], 1024, 1024, WT_O, 64 * kb, 32 * nb, 32 * nb, scr, lane); continue; } r -= IT_O;
                if (r < IT_F1) { const int kb = r / 176, nb = r % 176; const int n0 = 32 * nb; const int drow = n0 < DFF ? (n0 / 128) * 256 + (n0 % 128) : ((n0 - DFF) / 128) * 256 + 128 + ((n0 - DFF) % 128);
                    transpose_item(P.in[I_WF1], 1024, 5632, WT_F1, 64 * kb, n0, drow, scr, lane); continue; } r -= IT_F1;
                { const int kb = r / 32, nb = r % 32; transpose_item(P.in[I_WF2], 2816, 1024, WT_F2, 64 * kb, 32 * nb, 32 * nb, scr, lane); }
            }
        for (int i = (cu - 4) * 512 + tid; i < 128 * 120 * 32; i += (G - 4) * 512) { const int q = i & 31, j = (i >> 5) % 120, b = (i >> 5) / 120;
            const size_t src = ((size_t)(b * 128 + j + 8) * 128) + q * 4, dst = ((size_t)(b * 128 + j) * 128) + q * 4;
            *(f32x4*)(P.out + O_KWS + dst) = *(const f32x4*)(P.in[I_CK] + src); *(f32x4*)(P.out + O_VWS + dst) = *(const f32x4*)(P.in[I_CV] + src); }
        }
    }
    SEAM(1);
    LAS unsigned* qctr = (LAS unsigned*)(lds + 131072 + 528);
#define ATT_Q_RESET() do { __syncthreads(); if (tid == 0) *qctr = 0u; __syncthreads(); } while (0)
#define ATT_Q_NEXT() __builtin_amdgcn_readfirstlane(lane == 0 ? (int)__hip_atomic_fetch_add(qctr, 1u, __ATOMIC_RELAXED, __HIP_MEMORY_SCOPE_WORKGROUP) : 0)
    if (IN(2)) REPS(2) {
        for (int it = cu; it < 512; it += G) { hgrn_item<false>(lds, PROJ, HST, HDV, P.in[I_HNW], it, DRY); __syncthreads(); }
        for (int it = cu; it < 512; it += G) hgrn_sample_item(lds, PROJ, P.in[I_ST], P.out, P.in[I_HNW], it, DRY);
        ATT_Q_RESET();
        for (int it = ATT_Q_NEXT() * G + cu; it < 768; it = ATT_Q_NEXT() * G + cu) {
            if (it < 512) { AttMemS t{PROJ, P.in[I_CMK], P.in[I_CMV], it >> 2, it & 3, DRY}; attn_item(t); }
            else { const int r = it - 512; AttSwS t{PROJ, P.in[I_CK], P.in[I_CV], P.out + O_KWS, P.out + O_VWS, P.in[I_SINK], r >> 1, r & 1, DRY}; attn_item(t); }
        }
    }
    SEAM(2);
#define ATT_RUN(LO, HI, WS) do { const int ws_ = (WS), W_ = 240 * 16 + 16 * ws_, ns_ = cu < 16 ? ws_ : 16; ATT_Q_RESET(); \
        for (;;) { const int j_ = ATT_Q_NEXT(), q_ = j_ % ns_, it_ = (LO) + (j_ / ns_) * W_ + (cu < 16 ? 3840 + cu + 16 * q_ : (cu - 16) + 240 * q_); if (it_ >= (HI)) break; \
            if (it_ < 4096) { AttMemP t(PROJ, MKB, MVT, it_ >> 9, (it_ >> 7) & 3, it_ & 127, DRY); attn_item(t); } \
            else { const int r_ = it_ - 4096, hd_ = (r_ >> 7) & 7; AttSwP t(PROJ, VTSW, KSW, r_ >> 10, hd_, r_ & 127, fexp2(-(float)(hd_ + 1)) * LOG2E, P.in[I_SINK][hd_] * LOG2E, DRY); attn_item(t); } } } while (0)
    constexpr int ATT_SPLIT = 9000, ATT_TOTAL = 12288;
    if (IN(3)) REPS(3) {
        if (cu >= 16) for (int gt = (cu - 16) * 512 + tid; gt < 131072; gt += (G - 16) * 512) hgrn_scan(HST, HDV, P.out, gt, DRY);
        if (cu < 16) { SchedUpS S{512, NPJ, 128 + (cu >> 2), cu & 3, (const char*)PROJ, (const char*)WT_UP}; EpiUp E{PROJ, DRY}; pg8::gemm_phase(lds, S, E); }
        ATT_RUN(0, ATT_SPLIT, 1);
    }
    SEAM(3);
    if (IN(4)) REPS(4) {
        if (cu < 16) { SchedOne S{1024, NPJ, 128 + (cu >> 2), cu & 3, (const char*)(PROJ + C_MIX), (const char*)WT_O}; EpiRes E{PROJ, XN, 1024}; pg8::gemm_phase(lds, S, E); }
        ATT_RUN(ATT_SPLIT, ATT_TOTAL, 2);
    }
    SEAM(4);
    if (IN(5)) REPS(5) {
        for (int it = cu; it < 512; it += G) { hgrn_item<true>(lds, PROJ, HST, HDV, P.in[I_HNW], it, DRY); __syncthreads(); }
    }
    SEAM(5);
    if (IN(6)) REPS(6) { SchedUp S{512, NPJ, G, cu, (const char*)PROJ, (const char*)WT_UP}; EpiUp E{PROJ, DRY}; pg8::gemm_phase(lds, S, E); }
    SEAM(6);
    if (IN(7)) REPS(7) { SchedPlain S{1024, NPJ, G, cu, (const char*)(PROJ + C_MIX), (const char*)WT_O, 128, 4}; EpiRes E{PROJ, XN, 1024}; pg8::gemm_phase(lds, S, E); }
    SEAM(7);
    if (IN(8)) REPS(8) { for (int m = gw; m < MT; m += NGW) ln_row_bf16<false>(PROJ + (size_t)m * NPJ + C_Z, P.in[I_LN1W], P.in[I_LN1B], PROJ + (size_t)m * NPJ + C_H, lane); }
    SEAM(8);
    if (IN(9)) REPS(9) { SchedPlain S{1024, NPJ, G, cu, (const char*)(PROJ + C_H), (const char*)WT_F1, 132, 22};
#if PROBE_P8 == 1
        if (DRY) { EpiNull E0; pg8::gemm_phase(lds, S, E0); } else
#elif PROBE_P8 == 2
        if (DRY) { EpiGlu E0{PROJ, 1}; pg8::gemm_phase(lds, S, E0); } else
#endif
        { EpiGlu E{PROJ, 0}; pg8::gemm_phase(lds, S, E); } }
    SEAM(9);
    if (IN(10)) REPS(10) { SchedPlain S{2816, NPJ, G, cu, (const char*)(PROJ + C_ACT), (const char*)WT_F2, 128, 4}; EpiRes E{PROJ, PROJ + C_H, NPJ}; pg8::gemm_phase(lds, S, E); }
    SEAM(10);
    float* ZP = (float*)(P.ws + W_ZP);
    if (IN(11)) REPS(11) {
        if (cu < 32) { SchedHalfK S{1408, NPJ, 128 + (cu >> 3), (cu >> 1) & 3, cu & 1, (const char*)(PROJ + C_ACT), (const char*)WT_F2}; EpiPart E{ZP}; pg8::gemm_phase(lds, S, E); }
        else { for (int m = (cu - 32) * 8 + wave; m < MP; m += (G - 32) * 8) if (m < 7808 || m >= 9216) ln_row_bf16<true>(PROJ + (size_t)m * NPJ + C_Z, P.in[I_LN2W], P.in[I_LN2B], P.out + O_YP + (size_t)m * 1024, lane); }
    }
    SEAM(11);
    if (IN(12)) REPS(12) {
        for (int i = gw; i < 1408 + MS; i += NGW) {
            if (i < 1408) { const int m = 7808 + i; ln_row_bf16<true>(PROJ + (size_t)m * NPJ + C_Z, P.in[I_LN2W], P.in[I_LN2B], P.out + O_YP + (size_t)m * 1024, lane); }
            else { const int m = i - 1408; ln_row_sample(PROJ + (size_t)(MP + m) * NPJ + C_H, ZP + (size_t)m * 1024, ZP + (size_t)(1024 + m) * 1024, P.in[I_LN2W], P.in[I_LN2B], P.out + O_YS + (size_t)m * 1024, lane); }
        }
    }
}

#ifndef N_LAUNCH_MODE
#define N_LAUNCH_MODE 1
#endif
extern "C" void kernel_launch(void* const* d_in, const int* in_sizes, int n_in, void* d_out, int out_size, void* d_ws, size_t ws_size, hipStream_t stream) {
    static bool attr_done = false;
    if (!attr_done) { hipFuncSetAttribute((const void*)fwd_kernel, hipFuncAttributeMaxDynamicSharedMemorySize, LDS_BYTES); attr_done = true; }
    if (ws_size < W_END) { fprintf(stderr, "kernel_launch: workspace too small: %zu < %zu\n", ws_size, (size_t)W_END); }
    Params p{};
    for (int i = 0; i < 25; ++i) p.in[i] = (const float*)d_in[i];
    p.out = (float*)d_out; p.ws = (unsigned char*)d_ws;
    const int grid = 256;
#if N_LAUNCH_MODE == 1
    p.ph_lo = 0; p.ph_hi = 13;
    hipMemsetAsync((char*)d_ws + W_BAR, 0, 16384, stream);
    void* args[] = {&p};
    hipError_t e = hipLaunchCooperativeKernel((const void*)fwd_kernel, dim3(grid), dim3(512), args, LDS_BYTES, stream);
    if (e != hipSuccess) fprintf(stderr, "cooperative launch failed: %s\n", hipGetErrorString(e));
#else
    for (int ph = 0; ph < 13; ++ph) { p.ph_lo = ph; p.ph_hi = ph + 1; hipLaunchKernelGGL(fwd_kernel, dim3(grid), dim3(512), LDS_BYTES, stream, p); }
#endif
}
```
